# Optimizing an MI355X kernel written in HIP

```python
import jax, jax.numpy as jnp
from jax import lax
import numpy as np


D_MODEL = 1024
BATCH = 8
SEQ = 4096
DEPTH = 1

GLA_HEADS = 4
GLA_DK = D_MODEL // (2 * GLA_HEADS)
GLA_DV = D_MODEL // GLA_HEADS
GLA_GATE_RANK = 16
GLA_GATE_NORM = 16.0
GLA_CHUNK = 64
MLA_HEADS = 8
MLA_Q_RANK = 3 * D_MODEL // 8
MLA_KV_RANK = D_MODEL // 4
MLA_NOPE = D_MODEL // 16
MLA_ROPE = D_MODEL // 32
MLA_V = D_MODEL // MLA_HEADS
MLA_QBLOCK = 128
ROPE_THETA = 10000.0
D_FF = 4 * D_MODEL
EPS = 1e-6
POS_OFFSET_MAX = 1024

GLA_QK_W = GLA_HEADS * GLA_DK
GLA_V_W = GLA_HEADS * GLA_DV
MLA_QK_HEAD = MLA_NOPE + MLA_ROPE
SPLITS = (GLA_QK_W, GLA_QK_W, GLA_V_W, GLA_V_W, GLA_GATE_RANK, GLA_GATE_RANK,
          MLA_Q_RANK, MLA_KV_RANK, MLA_ROPE, D_MODEL, D_MODEL)
D_IN = sum(SPLITS)
SPLIT_IDX = tuple(int(i) for i in np.cumsum(SPLITS)[:-1])

kernel_name = 'hybrid_gla_mla_sqrelu_block'


def rmsnorm(x, g):
    xf = x.astype(jnp.float32)
    y = xf * lax.rsqrt(jnp.mean(xf * xf, axis=-1, keepdims=True) + EPS)
    return (y * g.astype(jnp.float32)).astype(x.dtype)


def rope(x, positions):
    half = x.shape[-1] // 2
    inv = ROPE_THETA ** (-jnp.arange(half, dtype=jnp.float32) / half)
    ang = positions.astype(jnp.float32)[:, :, None] * inv
    cos = jnp.cos(ang)[:, :, None, :]
    sin = jnp.sin(ang)[:, :, None, :]
    xf = x.astype(jnp.float32)
    x1, x2 = xf[..., :half], xf[..., half:]
    return jnp.concatenate([x1 * cos - x2 * sin, x1 * sin + x2 * cos], axis=-1).astype(x.dtype)


def gla_direction(q, k, v, log_a, include_diag):
    B, S, H, DK = q.shape
    DV = v.shape[-1]
    C = GLA_CHUNK
    N = S // C

    def chunks(t):
        return t.astype(jnp.float32).reshape(B, N, C, H, t.shape[-1]).transpose(0, 3, 1, 2, 4)

    q, k, v, log_a = chunks(q), chunks(k), chunks(v), chunks(log_a)
    b = jnp.cumsum(log_a, axis=3)
    b_last = b[:, :, :, -1:, :]
    q_dec = q * jnp.exp(b)
    k_dec = k * jnp.exp(-b)
    k_end = k * jnp.exp(b_last - b)
    mask = jnp.tril(jnp.ones((C, C), dtype=bool), 0 if include_diag else -1)
    scores = jnp.where(mask, jnp.einsum('bhnck,bhnsk->bhncs', q_dec, k_dec), 0.0)
    o_intra = jnp.einsum('bhncs,bhnsv->bhncv', scores, v)

    def step(state, inp):
        qc, kc, vc, dc = inp
        o = jnp.einsum('bhck,bhkv->bhcv', qc, state)
        state = state * dc[..., None] + jnp.einsum('bhck,bhcv->bhkv', kc, vc)
        return state, o

    to_scan = lambda t: jnp.moveaxis(t, 2, 0)
    state0 = jnp.zeros((B, H, DK, DV), jnp.float32)
    _, o_inter = lax.scan(step, state0, (to_scan(q_dec), to_scan(k_end), to_scan(v),
                                         to_scan(jnp.exp(b_last[:, :, :, 0, :]))))
    o = o_intra + jnp.moveaxis(o_inter, 0, 2)
    return o.transpose(0, 2, 3, 1, 4).reshape(B, S, H, DV)


def gla_branch(gq, gk, gv, gr, z_gf, z_gb, w_gate_f, b_gate_f, w_gate_b, b_gate_b, g_gla):
    B, S, _ = gq.shape
    heads = lambda t, d: t.reshape(B, S, GLA_HEADS, d)
    q = heads(gq, GLA_DK) * (GLA_DK ** -0.5)
    k = heads(gk, GLA_DK)
    v = heads(gv, GLA_DV)
    la_f = jax.nn.log_sigmoid((z_gf @ w_gate_f + b_gate_f).astype(jnp.float32)) / GLA_GATE_NORM
    la_b = jax.nn.log_sigmoid((z_gb @ w_gate_b + b_gate_b).astype(jnp.float32)) / GLA_GATE_NORM
    flip = lambda t: t[:, ::-1]
    o_f = gla_direction(q, k, v, heads(la_f, GLA_DK), True)
    o_b = flip(gla_direction(flip(q), flip(k), flip(v), flip(heads(la_b, GLA_DK)), False))
    o = rmsnorm(o_f + o_b, g_gla.reshape(GLA_HEADS, GLA_DV))
    o = o.reshape(B, S, GLA_V_W) * jax.nn.silu(gr.astype(jnp.float32))
    return o.astype(gq.dtype)


def mla_branch(cq, ckv, kr, positions, g_q, w_uq, g_kv, w_ukv):
    B, S, _ = cq.shape
    H = MLA_HEADS
    q = (rmsnorm(cq, g_q) @ w_uq).reshape(B, S, H, MLA_QK_HEAD)
    q = jnp.concatenate([q[..., :MLA_NOPE], rope(q[..., MLA_NOPE:], positions)], axis=-1)
    q = q * (MLA_QK_HEAD ** -0.5)
    kv = (rmsnorm(ckv, g_kv) @ w_ukv).reshape(B, S, H, MLA_NOPE + MLA_V)
    k_nope, v = kv[..., :MLA_NOPE], kv[..., MLA_NOPE:]
    k_rope = rope(kr[:, :, None, :], positions)
    k = jnp.concatenate([k_nope, jnp.broadcast_to(k_rope, (B, S, H, MLA_ROPE))], axis=-1)
    nb = S // MLA_QBLOCK
    qb = q.reshape(B, nb, MLA_QBLOCK, H, MLA_QK_HEAD).transpose(1, 0, 3, 2, 4)
    kt = k.transpose(0, 2, 1, 3)
    vt = v.transpose(0, 2, 1, 3)

    def attend(qblk):
        s = jnp.einsum('bhqd,bhkd->bhqk', qblk, kt).astype(jnp.float32)
        p = jax.nn.softmax(s, axis=-1)
        return jnp.einsum('bhqk,bhkv->bhqv', p.astype(vt.dtype), vt)

    o = lax.map(attend, qb)
    return o.transpose(1, 0, 3, 2, 4).reshape(B, S, H * MLA_V)


def setup_inputs(seed: int = 0) -> dict:
    key = jax.random.key(seed)
    ks = jax.random.split(key, 24)
    f32 = jnp.float32
    L = DEPTH
    nrm = lambda k, shape, fan: jax.random.normal(k, shape, f32) * (fan ** -0.5)
    gain = lambda k, shape: 1.0 + 0.02 * jax.random.normal(k, shape, f32)
    x = jax.random.normal(ks[0], (BATCH, SEQ, D_MODEL), f32)
    positions = (jnp.arange(SEQ, dtype=jnp.int32)[None, :]
                 + jax.random.randint(ks[1], (BATCH, 1), 0, POS_OFFSET_MAX, dtype=jnp.int32))
    return {
        'x': x,
        'positions': positions,
        'g_mix': gain(ks[2], (L, D_MODEL)),
        'w_in': nrm(ks[3], (L, D_MODEL, D_IN), D_MODEL),
        'w_gate_f': nrm(ks[4], (L, GLA_GATE_RANK, GLA_QK_W), GLA_GATE_RANK),
        'b_gate_f': 0.1 * jax.random.normal(ks[5], (L, GLA_QK_W), f32),
        'w_gate_b': nrm(ks[6], (L, GLA_GATE_RANK, GLA_QK_W), GLA_GATE_RANK),
        'b_gate_b': 0.1 * jax.random.normal(ks[7], (L, GLA_QK_W), f32),
        'g_gla': gain(ks[8], (L, GLA_V_W)),
        'g_q': gain(ks[9], (L, MLA_Q_RANK)),
        'w_uq': nrm(ks[10], (L, MLA_Q_RANK, MLA_HEADS * MLA_QK_HEAD), MLA_Q_RANK),
        'g_kv': gain(ks[11], (L, MLA_KV_RANK)),
        'w_ukv': nrm(ks[12], (L, MLA_KV_RANK, MLA_HEADS * (MLA_NOPE + MLA_V)), MLA_KV_RANK),
        'w_out': nrm(ks[13], (L, D_MODEL, D_MODEL), D_MODEL),
        'g_mlp': gain(ks[14], (L, D_MODEL)),
        'w_ff1': nrm(ks[15], (L, D_MODEL, D_FF), D_MODEL),
        'w_ff2': nrm(ks[16], (L, D_FF, D_MODEL), D_FF),
        'g_final': gain(ks[17], (D_MODEL,)),
    }


def reference(x, positions, g_mix, w_in, w_gate_f, b_gate_f, w_gate_b, b_gate_b, g_gla,
              g_q, w_uq, g_kv, w_ukv, w_out, g_mlp, w_ff1, w_ff2, g_final):
    h = x
    for l in range(DEPTH):
        n = rmsnorm(h, g_mix[l])
        proj = n @ w_in[l]
        (gq, gk, gv, gr, z_gf, z_gb, cq, ckv, kr, z_ma, z_mb) = jnp.split(proj, SPLIT_IDX, axis=-1)
        y_gla = gla_branch(gq, gk, gv, gr, z_gf, z_gb, w_gate_f[l], b_gate_f[l],
                           w_gate_b[l], b_gate_b[l], g_gla[l])
        y_mla = mla_branch(cq, ckv, kr, positions, g_q[l], w_uq[l], g_kv[l], w_ukv[l])
        merged = jax.nn.sigmoid(z_ma) * y_gla + jax.nn.sigmoid(z_mb) * y_mla
        h = h + merged @ w_out[l]
        m = rmsnorm(h, g_mlp[l])
        h = h + jnp.square(jax.nn.relu(m @ w_ff1[l])) @ w_ff2[l]
    return rmsnorm(h, g_final)
```

```cpp
#include <hip/hip_runtime.h>
#include <hip/hip_cooperative_groups.h>
#include <cstdio>
#include <cstdint>
namespace cg = cooperative_groups;

typedef unsigned short bf16_t;
typedef short bf16x8 __attribute__((ext_vector_type(8)));
typedef short s16x4 __attribute__((ext_vector_type(4)));
typedef float f32x2 __attribute__((ext_vector_type(2)));
typedef float f32x4 __attribute__((ext_vector_type(4)));
typedef float f32x8 __attribute__((ext_vector_type(8)));
typedef float f32x16 __attribute__((ext_vector_type(16)));
typedef unsigned u32x2 __attribute__((ext_vector_type(2)));
typedef unsigned u32x4 __attribute__((ext_vector_type(4)));
typedef _Float16 f16x8 __attribute__((ext_vector_type(8)));
#define DI __device__ __forceinline__
typedef __bf16 bf16x2_t __attribute__((ext_vector_type(2)));
DI unsigned cvt_pk_bf16(float lo, float hi) { f32x2 v = {lo, hi}; bf16x2_t b = __builtin_convertvector(v, bf16x2_t); return __builtin_bit_cast(unsigned, b); }
DI float bf2f(unsigned short b) { return __uint_as_float((unsigned)b << 16); }
DI float bflo(unsigned w) { return __uint_as_float(w << 16); }
DI float bfhi(unsigned w) { return __uint_as_float(w & 0xffff0000u); }
DI u32x4 pack8(const f32x4 a, const f32x4 b) { u32x4 w; w.x = cvt_pk_bf16(a[0], a[1]); w.y = cvt_pk_bf16(a[2], a[3]); w.z = cvt_pk_bf16(b[0], b[1]); w.w = cvt_pk_bf16(b[2], b[3]); return w; }
DI void unpack8(const u32x4 w, float* f) { f[0] = bflo(w.x); f[1] = bfhi(w.x); f[2] = bflo(w.y); f[3] = bfhi(w.y); f[4] = bflo(w.z); f[5] = bfhi(w.z); f[6] = bflo(w.w); f[7] = bfhi(w.w); }

namespace pg8 {
#define PG8_LAS __attribute__((address_space(3)))
constexpr int BM = 256, BK = 64, HALF = 128, HTB = HALF * BK * 2  , STAGE_BYTES = 8 * HTB, NXCD = 8, WGM = 8;
__host__ __device__ __forceinline__ int lds_byte(int r, int c) { const int st = (r >> 4) * 2 + (c >> 5), rr = r & 15, cc = c & 31, ob = rr * 64 + cc * 2; return st * 1024 + (ob ^ (((ob >> 9) & 1) << 5)); }
__host__ __device__ __forceinline__ void stage_rc(int b, int& R, int& C) { const int st = b / 1024, sb = b % 1024, swz = sb ^ (((sb >> 9) & 1) << 5); R = (st >> 1) * 16 + swz / 64; C = (st & 1) * 32 + (swz % 64) / 2; }
__host__ __device__ __forceinline__ int perm32(int rho) { const int n = rho >> 4, i = rho & 15; return 8 * (i >> 2) + 4 * n + (i & 3); }
struct Unit { int pm, pn; };
struct Gemm { const bf16_t* A; const bf16_t* Bt; int M, N, K, lda, ldb; unsigned akstep = 0, atstep = 0, bkstep = 0, btstep = 0; };
struct StaticOrder {
    int nM, nN, nwg, G, c;
    __host__ __device__ void init(int M, int N, int G_, int c_) { nM = M / BM; nN = N / BM; nwg = nM * nN; G = G_; c = c_; }
    __host__ __device__ bool next(int i, Unit& u) const {
        const long L = (long)i * G + c; if (L >= nwg) return false;
        int wgid = (int)L; { const int q = nwg / NXCD, r = nwg % NXCD, xcd = wgid % NXCD, off = wgid / NXCD; wgid = (xcd < r ? xcd * (q + 1) : r * (q + 1) + (xcd - r) * q) + off; }
        const int nig = WGM * nN, gid = wgid / nig, fm = gid * WGM, gsz = (nM - fm) < WGM ? (nM - fm) : WGM;
        u.pm = fm + ((wgid % nig) % gsz); u.pn = (wgid % nig) / gsz; return true;
    }
    __device__ __forceinline__ void a_ready(const Unit&) const {}
    __device__ __forceinline__ void done(const Unit&) const {}
};
struct ReverseOrder {
    StaticOrder S; int nr; bool rev;
    __host__ __device__ void init(int M, int N, int G_, int c_) { S.init(M, N, G_, c_); nr = S.nwg / G_; rev = (nr * G_ == S.nwg); }
    __host__ __device__ bool next(int i, Unit& u) const { if (!rev) return S.next(i, u); if (i >= nr) return false; return S.next(nr - 1 - i, u); }
    __device__ __forceinline__ void a_ready(const Unit&) const {}
    __device__ __forceinline__ void done(const Unit&) const {}
};
template <class Epi, class Sched, bool ALIGN_EPI = false, bool SP2 = false>
__device__ __forceinline__ void gemm_phase(PG8_LAS unsigned char* lds, const Gemm g, const Sched& S, const Epi& E) {
    const int tid = threadIdx.x, wid = __builtin_amdgcn_readfirstlane(tid >> 6), lane = tid & 63, wr = wid >> 2, wc = wid & 3, fr = lane & 15, fq = lane >> 4;
    int nt = g.K / BK; asm volatile("" : "+s"(nt));
    unsigned voffA[2], voffB[2];
#pragma unroll
    for (int i = 0; i < 2; ++i) { int R, C; stage_rc(tid * 16 + i * 8192, R, C); const int Rb = Epi::PERM ? ((R & ~31) + perm32(R & 31)) : R;
        voffA[i] = (unsigned)(R * g.lda + C) * 2u; voffB[i] = (unsigned)(Rb * g.ldb + C) * 2u; }
    const size_t kstep = (size_t)(BK * 2);
    const size_t kstepA = g.akstep ? (size_t)g.akstep : kstep, kstepB = g.bkstep ? (size_t)g.bkstep : kstep;
    const size_t hstepA = (size_t)HALF * g.lda * 2, hstepB = (size_t)HALF * g.ldb * 2;
    const size_t tstepA = g.atstep ? (size_t)g.atstep : 2 * hstepA, tstepB = g.btstep ? (size_t)g.btstep : 2 * hstepB;
    const unsigned ldsw = (unsigned)wid * 1024u;
    const int aoff = lds_byte(wr * 64 + fr, fq * 8), boff = lds_byte(wc * 32 + fr, fq * 8);
#define PG8_SA(b, h) (((b) * 2 + (h)) * HTB)
#define PG8_SB(b, h) ((4 + (b) * 2 + (h)) * HTB)
#define PG8_STAGE(bufoff, gbase, voff) do { _Pragma("unroll") for (int _i = 0; _i < 2; ++_i) \
        __builtin_amdgcn_global_load_lds((const unsigned*)((const char*)(gbase) + (voff)[_i]), (PG8_LAS unsigned*)(lds + (bufoff) + ldsw + _i * 8192), 16, 0, 0); } while (0)
#define PG8_LDA(dst, b, h) do { _Pragma("unroll") for (int m = 0; m < 4; ++m) _Pragma("unroll") for (int k = 0; k < 2; ++k) dst[m][k] = *(const PG8_LAS bf16x8*)(lds + PG8_SA(b, h) + aoff + m * 2048 + k * 1024); } while (0)
#define PG8_LDB(dst, b, h) do { _Pragma("unroll") for (int n = 0; n < 2; ++n) _Pragma("unroll") for (int k = 0; k < 2; ++k) dst[n][k] = *(const PG8_LAS bf16x8*)(lds + PG8_SB(b, h) + boff + n * 2048 + k * 1024); } while (0)
#define PG8_MMA(ai, bj, At, Bt) do { __builtin_amdgcn_s_setprio(1); _Pragma("unroll") for (int m = 0; m < 4; ++m) _Pragma("unroll") for (int n = 0; n < 2; ++n) _Pragma("unroll") for (int k = 0; k < 2; ++k) \
        acc[ai][bj][m][n] = __builtin_amdgcn_mfma_f32_16x16x32_bf16(Bt[n][k], At[m][k], acc[ai][bj][m][n], 0, 0, 0); __builtin_amdgcn_s_setprio(0); } while (0)
#define PG8_WAIT_V(n) asm volatile("s_waitcnt vmcnt(" #n ")" ::: "memory")
#define PG8_WAIT_L(n) asm volatile("s_waitcnt lgkmcnt(" #n ")" ::: "memory")
#define PG8_BAR __builtin_amdgcn_s_barrier()
#define PG8_SCHED __builtin_amdgcn_sched_barrier(0)
    Unit cur, nxt; int ui = 0;
    if (!S.next(0, cur)) return;
    f32x4 acc[2][2][4][2];
#pragma unroll
    for (int a = 0; a < 2; ++a)
#pragma unroll
        for (int b = 0; b < 2; ++b)
#pragma unroll
            for (int m = 0; m < 4; ++m)
#pragma unroll
                for (int n = 0; n < 2; ++n) acc[a][b][m][n] = (f32x4){0.f, 0.f, 0.f, 0.f};
    bf16x8 At[4][2], B0[2][2], B1[2][2];
    const char* cA = (const char*)g.A + (size_t)cur.pm * tstepA; const char* cB = (const char*)g.Bt + (size_t)cur.pn * tstepB;
    S.a_ready(cur);
    if constexpr (SP2) {
        PG8_STAGE(PG8_SB(0, 0), cB, voffB); PG8_STAGE(PG8_SB(0, 1), cB + hstepB, voffB); PG8_STAGE(PG8_SA(0, 0), cA, voffA); PG8_STAGE(PG8_SA(0, 1), cA + hstepA, voffA);
        if (wr == 1) PG8_BAR;
        PG8_WAIT_V(2); PG8_BAR;
        PG8_STAGE(PG8_SB(1, 0), cB + kstepB, voffB); PG8_STAGE(PG8_SA(1, 0), cA + kstepA, voffA); PG8_STAGE(PG8_SB(1, 1), cB + hstepB + kstepB, voffB);
        PG8_WAIT_V(6); PG8_BAR;
    } else {
        PG8_STAGE(PG8_SB(0, 0), cB, voffB); PG8_STAGE(PG8_SA(0, 0), cA, voffA); PG8_STAGE(PG8_SB(0, 1), cB + hstepB, voffB); PG8_STAGE(PG8_SA(0, 1), cA + hstepA, voffA);
        if (wr == 1) PG8_BAR;
        PG8_WAIT_V(4); PG8_BAR;
        PG8_STAGE(PG8_SB(1, 0), cB + kstepB, voffB); PG8_STAGE(PG8_SA(1, 0), cA + kstepA, voffA); PG8_STAGE(PG8_SB(1, 1), cB + hstepB + kstepB, voffB);
        PG8_WAIT_V(6); PG8_BAR;
    }
    for (;;) {
        const bool has_next = S.next(ui + 1, nxt);
        const char* nA = has_next ? (const char*)g.A + (size_t)nxt.pm * tstepA : cA; const char* nB = has_next ? (const char*)g.Bt + (size_t)nxt.pn * tstepB : cB;
        for (int t = 0; t < nt; t += 2) {
            const bool last = (t == nt - 2);
            const char* a1 = cA + (size_t)(t + 1) * kstepA;
            const char* a2 = last ? nA : cA + (size_t)(t + 2) * kstepA; const char* b2 = last ? nB : cB + (size_t)(t + 2) * kstepB;
            const char* a3 = a2 + kstepA; const char* b3 = b2 + kstepB;
            if (last && has_next) S.a_ready(nxt);
            if constexpr (SP2) {
            PG8_LDB(B0, 0, 0); PG8_LDB(B1, 0, 1); PG8_SCHED; PG8_LDA(At, 0, 0); PG8_STAGE(PG8_SA(1, 1), a1 + hstepA, voffA);
            PG8_WAIT_V(8); PG8_WAIT_L(0); PG8_BAR; PG8_MMA(0, 0, At, B0); PG8_MMA(0, 1, At, B1); PG8_BAR; PG8_SCHED;
            PG8_LDA(At, 0, 1); PG8_STAGE(PG8_SB(0, 0), b2, voffB); PG8_STAGE(PG8_SB(0, 1), b2 + hstepB, voffB); PG8_STAGE(PG8_SA(0, 0), a2, voffA);
            PG8_WAIT_V(8); PG8_WAIT_L(0); PG8_BAR; PG8_MMA(1, 0, At, B0); PG8_MMA(1, 1, At, B1); PG8_BAR; PG8_SCHED;
            PG8_LDB(B0, 1, 0); PG8_LDB(B1, 1, 1); PG8_SCHED; PG8_LDA(At, 1, 0); PG8_STAGE(PG8_SA(0, 1), a2 + hstepA, voffA);
            PG8_WAIT_V(8); PG8_WAIT_L(0); PG8_BAR; PG8_MMA(0, 0, At, B0); PG8_MMA(0, 1, At, B1); PG8_BAR; PG8_SCHED;
            PG8_LDA(At, 1, 1); PG8_STAGE(PG8_SB(1, 0), b3, voffB); PG8_STAGE(PG8_SB(1, 1), b3 + hstepB, voffB); PG8_STAGE(PG8_SA(1, 0), a3, voffA);
            PG8_WAIT_V(8); PG8_WAIT_L(0); PG8_BAR; PG8_MMA(1, 0, At, B0); PG8_MMA(1, 1, At, B1); PG8_BAR; PG8_SCHED;
            } else {
            PG8_LDB(B0, 0, 0); PG8_SCHED; PG8_LDA(At, 0, 0); PG8_STAGE(PG8_SA(1, 1), a1 + hstepA, voffA);
            PG8_WAIT_L(8); PG8_BAR; PG8_WAIT_L(0); PG8_MMA(0, 0, At, B0); PG8_BAR; PG8_SCHED;
            PG8_LDB(B1, 0, 1); PG8_STAGE(PG8_SB(0, 0), b2, voffB);
            PG8_BAR; PG8_WAIT_L(0); PG8_MMA(0, 1, At, B1); PG8_BAR;
            PG8_LDA(At, 0, 1); PG8_STAGE(PG8_SA(0, 0), a2, voffA);
            PG8_BAR; PG8_WAIT_L(0); PG8_MMA(1, 0, At, B0); PG8_BAR; PG8_SCHED;
            PG8_STAGE(PG8_SB(0, 1), b2 + hstepB, voffB);
            PG8_WAIT_V(6); PG8_BAR; PG8_MMA(1, 1, At, B1); PG8_BAR;
            PG8_LDB(B0, 1, 0); PG8_SCHED; PG8_LDA(At, 1, 0); PG8_STAGE(PG8_SA(0, 1), a2 + hstepA, voffA);
            PG8_WAIT_L(8); PG8_BAR; PG8_WAIT_L(0); PG8_MMA(0, 0, At, B0); PG8_BAR; PG8_SCHED;
            PG8_LDB(B1, 1, 1); PG8_STAGE(PG8_SB(1, 0), b3, voffB);
            PG8_BAR; PG8_WAIT_L(0); PG8_MMA(0, 1, At, B1); PG8_BAR;
            PG8_LDA(At, 1, 1); PG8_STAGE(PG8_SA(1, 0), a3, voffA);
            PG8_BAR; PG8_WAIT_L(0); PG8_MMA(1, 0, At, B0); PG8_BAR; PG8_SCHED;
            PG8_STAGE(PG8_SB(1, 1), b3 + hstepB, voffB);
            PG8_WAIT_V(6); PG8_BAR; PG8_MMA(1, 1, At, B1); PG8_BAR;
            }
        }
        if constexpr (ALIGN_EPI) { if (wr == 0) PG8_BAR; }
        if constexpr (!Epi::AFTER_DRAIN) { E(acc, cur, wr, wc, fr, fq); S.done(cur); }
        if (!has_next) break;
#pragma unroll
        for (int a = 0; a < 2; ++a)
#pragma unroll
            for (int b = 0; b < 2; ++b)
#pragma unroll
                for (int m = 0; m < 4; ++m)
#pragma unroll
                    for (int n = 0; n < 2; ++n) acc[a][b][m][n] = (f32x4){0.f, 0.f, 0.f, 0.f};
        cur = nxt; cA = nA; cB = nB; ++ui;
        if constexpr (ALIGN_EPI) { if (wr == 1) PG8_BAR; }
    }
    PG8_WAIT_V(0);
    if constexpr (!ALIGN_EPI) { if (wr == 0) PG8_BAR; }
    PG8_BAR;
    if constexpr (Epi::AFTER_DRAIN) { E.fused(acc, cur, wr, wc, fr, fq, lds, wid, lane); S.done(cur); }
#undef PG8_SA
#undef PG8_SB
#undef PG8_STAGE
#undef PG8_LDA
#undef PG8_LDB
#undef PG8_MMA
#undef PG8_WAIT_V
#undef PG8_WAIT_L
#undef PG8_BAR
#undef PG8_SCHED
}
}
using pg8::Unit;
#define LAS __attribute__((address_space(3)))
#define LDS_WAIT() asm volatile("s_waitcnt lgkmcnt(0)" ::: "memory")

constexpr int NBATCH = 8, SEQ = 4096, T = NBATCH * SEQ, DM = 1024, DFF = 4096;
constexpr int NA = 2816, NG = 3072;
constexpr int LDSM = 768;
constexpr float EPS = 1e-6f, LOG2E = 1.4426950408889634f;
constexpr float QSCALE = 0.10206207261596575f * LOG2E;
constexpr float GLA_QSCALE = 0.08838834764831845f;
constexpr int NWAVES = 8, NTHR = 512;
constexpr int LDS_BYTES = 147456, LDS_MISC = 131072;

constexpr size_t MiB = 1u << 20;
constexpr size_t WS_WINA = 0, WS_WINB = 6 * MiB, WS_WUQ = 12 * MiB, WS_WUKV = 13 * MiB, WS_WOUT = 14 * MiB, WS_W1 = 16 * MiB, WS_W2 = 24 * MiB;
constexpr size_t WS_ROPEC = 33 * MiB, WS_ROPES = 35 * MiB, WS_SSQ = 37 * MiB, WS_CTL = 37 * MiB + 512 * 1024;
constexpr size_t WS_XN = 38 * MiB, WS_MERGED = 38 * MiB;
constexpr size_t WS_GQKV = 102 * MiB, WS_K = 230 * MiB, WS_V = 278 * MiB, WS_GATES = 102 * MiB, WS_U = 102 * MiB;
constexpr size_t WS_QO = 342 * MiB, WS_SMALL = 406 * MiB, WS_OB = 406 * MiB, WS_HB = 406 * MiB, WS_END = 470 * MiB;
constexpr int LDU = DFF + 64;

struct Args { const float* x; const int* pos; const float *g_mix, *w_in, *w_gate_f, *b_gate_f, *w_gate_b, *b_gate_b, *g_gla, *g_q, *w_uq, *g_kv, *w_ukv, *w_out, *g_mlp, *w_ff1, *w_ff2, *g_final;
              float* out; unsigned char* ws; int ph_lo, ph_hi; };

DI float wave_sum(float v) {
#pragma unroll
    for (int o = 1; o < 64; o <<= 1) v += __shfl_xor(v, o);
    return v;
}
DI float sigmoidf_(float x) { return __builtin_amdgcn_rcpf(1.0f + __builtin_amdgcn_exp2f(-LOG2E * x)); }
DI float logsig2_(float x) { return fminf(x, 0.f) * LOG2E - __builtin_amdgcn_logf(1.0f + __builtin_amdgcn_exp2f(-LOG2E * fabsf(x))); }

struct EpiP1a {
    static constexpr bool PERM = true, AFTER_DRAIN = false;
    bf16_t* gqkv; bf16_t* small; float* ssq_q; float* ssq_kv;
    DI void operator()(const f32x4 (&acc)[2][2][4][2], const Unit& u, int wr, int wc, int fr, int fq) const {
        const int row0 = u.pm * 256 + wr * 64 + fr;
#pragma unroll
        for (int bj = 0; bj < 2; ++bj) {
            const int gc = u.pn * 256 + bj * 128 + wc * 32;
            bf16_t* base; int ld, c; float* ssq = nullptr;
            if (gc < 2048) { base = gqkv; ld = 2048; c = gc; }
            else { base = small; ld = LDSM; c = gc - 2048; if (c >= 32 && c < 416) ssq = ssq_q; else if (c >= 416 && c < 672) ssq = ssq_kv; }
#pragma unroll
            for (int ai = 0; ai < 2; ++ai)
#pragma unroll
                for (int m = 0; m < 4; ++m) {
                    const int row = row0 + ai * 128 + m * 16;
                    const f32x4 v0 = acc[ai][bj][m][0], v1 = acc[ai][bj][m][1];
                    *(u32x4*)(base + (size_t)row * ld + c + 8 * fq) = pack8(v0, v1);
                    if (ssq) {
                        float s = (v0[0] * v0[0] + v0[1] * v0[1]) + (v0[2] * v0[2] + v0[3] * v0[3]) + (v1[0] * v1[0] + v1[1] * v1[1]) + (v1[2] * v1[2] + v1[3] * v1[3]);
                        s += __shfl_xor(s, 16); s += __shfl_xor(s, 32);
                        if (fq == 0) atomicAdd(ssq + row, s);
                    }
                }
        }
    }
};
struct EpiGates {
    static constexpr bool PERM = true, AFTER_DRAIN = false;
    bf16_t* gates;
    DI void operator()(const f32x4 (&acc)[2][2][4][2], const Unit& u, int wr, int wc, int fr, int fq) const {
        const int row0 = u.pm * 256 + wr * 64 + fr;
#pragma unroll
        for (int bj = 0; bj < 2; ++bj) {
            const int gc = u.pn * 256 + bj * 128 + wc * 32; const bool is_silu = gc < 1024;
#pragma unroll
            for (int ai = 0; ai < 2; ++ai)
#pragma unroll
                for (int m = 0; m < 4; ++m) {
                    const int row = row0 + ai * 128 + m * 16;
                    f32x4 v0 = acc[ai][bj][m][0], v1 = acc[ai][bj][m][1];
#pragma unroll
                    for (int e = 0; e < 4; ++e) { const float s0 = sigmoidf_(v0[e]), s1 = sigmoidf_(v1[e]); v0[e] = is_silu ? v0[e] * s0 : s0; v1[e] = is_silu ? v1[e] * s1 : s1; }
                    *(u32x4*)(gates + (size_t)row * NG + gc + 8 * fq) = pack8(v0, v1);
                }
        }
    }
};
struct EpiQ {
    static constexpr bool PERM = true, AFTER_DRAIN = false;
    bf16_t* qo; const float* ssq; const float* rc; const float* rsn;
    DI void operator()(const f32x4 (&acc)[2][2][4][2], const Unit& u, int wr, int wc, int fr, int fq) const {
        const int row0 = u.pm * 256 + wr * 64 + fr;
#pragma unroll
        for (int bj = 0; bj < 2; ++bj) {
            const int gc = u.pn * 256 + bj * 128 + wc * 32; const int h = gc / 96, j0 = gc - h * 96; const bool rope = (j0 == 64);
            const int dcol = h * 128 + j0 + 8 * fq;
#pragma unroll
            for (int ai = 0; ai < 2; ++ai)
#pragma unroll
                for (int m = 0; m < 4; ++m) {
                    const int row = row0 + ai * 128 + m * 16;
                    const float rs = rsqrtf(ssq[row] * (1.0f / 384.0f) + EPS);
                    f32x4 v0 = acc[ai][bj][m][0] * rs, v1 = acc[ai][bj][m][1] * rs;
                    if (rope) {
                        const int i0 = 8 * (fq & 1);
                        const f32x4 c0 = *(const f32x4*)(rc + (size_t)row * 16 + i0), c1 = *(const f32x4*)(rc + (size_t)row * 16 + i0 + 4);
                        const f32x4 s0 = *(const f32x4*)(rsn + (size_t)row * 16 + i0), s1 = *(const f32x4*)(rsn + (size_t)row * 16 + i0 + 4);
                        const float sg = (fq < 2) ? -1.0f : 1.0f;
                        f32x4 p0, p1;
#pragma unroll
                        for (int e = 0; e < 4; ++e) { p0[e] = __shfl_xor(v0[e], 32); p1[e] = __shfl_xor(v1[e], 32); }
                        v0 = v0 * c0 + (p0 * s0) * sg; v1 = v1 * c1 + (p1 * s1) * sg;
                    }
                    v0 = v0 * QSCALE; v1 = v1 * QSCALE;
                    *(u32x4*)(qo + (size_t)row * 1024 + dcol) = pack8(v0, v1);
                    asm volatile("" ::: "memory");
                }
        }
    }
};
struct EpiKV {
    static constexpr bool PERM = true, AFTER_DRAIN = false;
    bf16_t* kb; bf16_t* vb; const float* ssq;
    DI void operator()(const f32x4 (&acc)[2][2][4][2], const Unit& u, int wr, int wc, int fr, int fq) const {
        const int row0 = u.pm * 256 + wr * 64 + fr;
#pragma unroll
        for (int bj = 0; bj < 2; ++bj) {
            const int gc = u.pn * 256 + bj * 128 + wc * 32; const int h = gc / 192, j0 = gc - h * 192;
            bf16_t* base; int ld, c;
            if (j0 < 64) { base = kb; ld = 768; c = h * 96 + j0 + 8 * fq; } else { base = vb; ld = 1024; c = h * 128 + (j0 - 64) + 8 * fq; }
#pragma unroll
            for (int ai = 0; ai < 2; ++ai)
#pragma unroll
                for (int m = 0; m < 4; ++m) {
                    const int row = row0 + ai * 128 + m * 16;
                    const float rs = rsqrtf(ssq[row] * (1.0f / 256.0f) + EPS);
                    *(u32x4*)(base + (size_t)row * ld + c) = pack8(acc[ai][bj][m][0] * rs, acc[ai][bj][m][1] * rs);
                }
        }
    }
};
template <bool WRITE_HB> struct EpiRes {
    static constexpr bool PERM = true, AFTER_DRAIN = false;
    const float* base; float* out; bf16_t* hb; float* ssq;
    DI void operator()(const f32x4 (&acc)[2][2][4][2], const Unit& u, int wr, int wc, int fr, int fq) const {
        const int row0 = u.pm * 256 + wr * 64 + fr; const int colb = u.pn * 256 + wc * 32 + 8 * fq;
#pragma unroll
        for (int ai = 0; ai < 2; ++ai) {
            f32x4 pre[4][2][2];
#pragma unroll
            for (int m = 0; m < 4; ++m)
#pragma unroll
                for (int bj = 0; bj < 2; ++bj) { const size_t off = (size_t)(row0 + ai * 128 + m * 16) * DM + colb + bj * 128;
                    pre[m][bj][0] = *(const f32x4*)(base + off); pre[m][bj][1] = *(const f32x4*)(base + off + 4); }
            asm volatile("" ::: "memory");
#pragma unroll
            for (int m = 0; m < 4; ++m) {
                const int row = row0 + ai * 128 + m * 16; float s = 0.f;
#pragma unroll
                for (int bj = 0; bj < 2; ++bj) {
                    const size_t off = (size_t)row * DM + colb + bj * 128;
                    const f32x4 v0 = pre[m][bj][0] + acc[ai][bj][m][0], v1 = pre[m][bj][1] + acc[ai][bj][m][1];
                    *(f32x4*)(out + off) = v0; *(f32x4*)(out + off + 4) = v1;
                    if (WRITE_HB) *(u32x4*)(hb + off) = pack8(v0, v1);
                    s += (v0[0] * v0[0] + v0[1] * v0[1]) + (v0[2] * v0[2] + v0[3] * v0[3]) + (v1[0] * v1[0] + v1[1] * v1[1]) + (v1[2] * v1[2] + v1[3] * v1[3]);
                }
                s += __shfl_xor(s, 16); s += __shfl_xor(s, 32);
                if (fq == 0) atomicAdd(ssq + row, s);
            }
            asm volatile("" ::: "memory");
        }
    }
};
template <bool BASE_BF16> struct EpiResB {
    static constexpr bool PERM = true, AFTER_DRAIN = false;
    const void* base; bf16_t* hb; float* ssq;
    DI void operator()(const f32x4 (&acc)[2][2][4][2], const Unit& u, int wr, int wc, int fr, int fq) const {
        const int row0 = u.pm * 256 + wr * 64 + fr; const int colb = u.pn * 256 + wc * 32 + 8 * fq;
#pragma unroll
        for (int ai = 0; ai < 2; ++ai) {
            f32x4 pre[4][2][2];
#pragma unroll
            for (int m = 0; m < 4; ++m)
#pragma unroll
                for (int bj = 0; bj < 2; ++bj) { const size_t off = (size_t)(row0 + ai * 128 + m * 16) * DM + colb + bj * 128;
                    if (BASE_BF16) { float f[8]; unpack8(*(const u32x4*)((const bf16_t*)base + off), f); pre[m][bj][0] = (f32x4){f[0], f[1], f[2], f[3]}; pre[m][bj][1] = (f32x4){f[4], f[5], f[6], f[7]}; }
                    else { pre[m][bj][0] = *(const f32x4*)((const float*)base + off); pre[m][bj][1] = *(const f32x4*)((const float*)base + off + 4); } }
            asm volatile("" ::: "memory");
#pragma unroll
            for (int m = 0; m < 4; ++m) {
                const int row = row0 + ai * 128 + m * 16; float s = 0.f;
#pragma unroll
                for (int bj = 0; bj < 2; ++bj) {
                    const size_t off = (size_t)row * DM + colb + bj * 128;
                    const f32x4 v0 = pre[m][bj][0] + acc[ai][bj][m][0], v1 = pre[m][bj][1] + acc[ai][bj][m][1];
                    *(u32x4*)(hb + off) = pack8(v0, v1);
                    s += (v0[0] * v0[0] + v0[1] * v0[1]) + (v0[2] * v0[2] + v0[3] * v0[3]) + (v1[0] * v1[0] + v1[1] * v1[1]) + (v1[2] * v1[2] + v1[3] * v1[3]);
                }
                if (ssq) { s += __shfl_xor(s, 16); s += __shfl_xor(s, 32);
                    if (fq == 0) atomicAdd(ssq + row, s); }
            }
            asm volatile("" ::: "memory");
        }
    }
};
struct EpiFF1 {
    static constexpr bool PERM = true, AFTER_DRAIN = false;
    bf16_t* ub; const float* ssq;
    DI void operator()(const f32x4 (&acc)[2][2][4][2], const Unit& u, int wr, int wc, int fr, int fq) const {
        const int row0 = u.pm * 256 + wr * 64 + fr;
#pragma unroll
        for (int ai = 0; ai < 2; ++ai)
#pragma unroll
            for (int m = 0; m < 4; ++m) {
                const int row = row0 + ai * 128 + m * 16;
                const float rs = rsqrtf(ssq[row] * (1.0f / 1024.0f) + EPS);
#pragma unroll
                for (int bj = 0; bj < 2; ++bj) {
                    f32x4 v0 = acc[ai][bj][m][0] * rs, v1 = acc[ai][bj][m][1] * rs;
#pragma unroll
                    for (int e = 0; e < 4; ++e) { const float a = fmaxf(v0[e], 0.f), b = fmaxf(v1[e], 0.f); v0[e] = a * a; v1[e] = b * b; }
                    { const int col = u.pn * 256 + bj * 128 + wc * 32 + 8 * fq;
                      *(u32x4*)(ub + (((size_t)(row >> 8) * (DFF / 64) + (col >> 6)) * 256 + (row & 255)) * 64 + (col & 63)) = pack8(v0, v1); }
                }
            }
    }
};

namespace att {
constexpr int QBLK = 32, KVBLK = 64, LDQ = 1024, LDKK = 768, LDKV = 1024;
#ifndef ATT_SDEPTH
#define ATT_SDEPTH 1
#endif
constexpr int SDEPTH = ATT_SDEPTH;
constexpr float THRL = 11.5f;
constexpr size_t SHM_V = KVBLK * 128 * 2, SHM_K = KVBLK * 256, SHM_ATTN = 3 * SHM_V + 3 * SHM_K + NWAVES * 64 * 4;
#define KSWZ(row, colB) ((row) * 256 + ((colB) ^ (((row) & 15) << 4)))
#define SBAR() __builtin_amdgcn_sched_barrier(0)
DI int crow(int r, int hi) { return (r & 3) + 8 * (r >> 2) + 4 * hi; }
DI void partialSM(f32x16& p0, f32x16& p1, float& m_reg, float& mn, float& alpha) {
  float pmax = p0[0];
#pragma unroll
  for (int r = 1; r < 16; ++r) pmax = fmaxf(pmax, p0[r]);
#pragma unroll
  for (int r = 0; r < 16; ++r) pmax = fmaxf(pmax, p1[r]);
  { auto rr = __builtin_amdgcn_permlane32_swap(__float_as_uint(pmax), __float_as_uint(pmax), false, false);
    pmax = fmaxf(__uint_as_float(rr[0]), __uint_as_float(rr[1])); }
  if (__builtin_expect(__all(pmax - m_reg <= THRL), 1)) { mn = m_reg; alpha = 1.f; }
  else { mn = fmaxf(m_reg, pmax); alpha = __builtin_amdgcn_exp2f(m_reg - mn); m_reg = mn; }
#pragma unroll
  for (int r = 0; r < 16; ++r) p0[r] = p0[r] - mn;
#pragma unroll
  for (int r = 0; r < 16; ++r) p1[r] = p1[r] - mn;
#pragma unroll
  for (int r = 0; r < 16; ++r) p0[r] = __builtin_amdgcn_exp2f(p0[r]);
}
DI void finishSM(f32x16& p0, f32x16& p1, float alpha, float& l_reg, bf16x8& pa0, bf16x8& pa1, bf16x8& pa2, bf16x8& pa3) {
#pragma unroll
  for (int r = 0; r < 16; ++r) p1[r] = __builtin_amdgcn_exp2f(p1[r]);
  float ps = 0;
#pragma unroll
  for (int r = 0; r < 16; ++r) ps += p0[r];
#pragma unroll
  for (int r = 0; r < 16; ++r) ps += p1[r];
  { auto rr = __builtin_amdgcn_permlane32_swap(__float_as_uint(ps), __float_as_uint(ps), false, false);
    ps = __uint_as_float(rr[0]) + __uint_as_float(rr[1]); }
  l_reg = l_reg * alpha + ps;
#define PK4(P, BASE, OUT) do { unsigned a0 = cvt_pk_bf16(P[BASE + 0], P[BASE + 1]), a1 = cvt_pk_bf16(P[BASE + 2], P[BASE + 3]);   \
    unsigned b0 = cvt_pk_bf16(P[BASE + 4], P[BASE + 5]), b1 = cvt_pk_bf16(P[BASE + 6], P[BASE + 7]);                              \
    auto r0 = __builtin_amdgcn_permlane32_swap(a0, b0, false, false); auto r1 = __builtin_amdgcn_permlane32_swap(a1, b1, false, false); \
    u32x4 w = {r0[0], r1[0], r0[1], r1[1]}; OUT = *reinterpret_cast<bf16x8*>(&w); } while (0)
  PK4(p0, 0, pa0); PK4(p0, 8, pa1); PK4(p1, 0, pa2); PK4(p1, 8, pa3);
#undef PK4
}
DI void qkt(f32x16& p0, f32x16& p1, const bf16_t* Ks, const bf16x8* qr, int r32, int hi) {
  p0 = f32x16{}; p1 = f32x16{};
#pragma unroll
  for (int d0 = 0; d0 < 6; ++d0) { const int cb = (d0 * 16 + hi * 8) * 2;
    bf16x8 b0 = *reinterpret_cast<const bf16x8*>((const char*)Ks + KSWZ(r32, cb));
    bf16x8 b1 = *reinterpret_cast<const bf16x8*>((const char*)Ks + KSWZ(32 + r32, cb));
    p0 = __builtin_amdgcn_mfma_f32_32x32x16_bf16(b0, qr[d0], p0, 0, 0, 0);
    p1 = __builtin_amdgcn_mfma_f32_32x32x16_bf16(b1, qr[d0], p1, 0, 0, 0); }
}
DI int v_st(int k, int c) { const int kk = (k & ~0xC) | ((k & 4) << 1) | ((k & 8) >> 1); return ((kk >> 3) * 4 + (c >> 5)) * 512 + ((kk & 7) * 32 + (c & 31)) * 2; }
DI int v_rd_base(int lane) { return ((lane & 3) << 3) | (((lane >> 2) & 3) << 6) | (((lane >> 4) & 1) << 5) | (((lane >> 5) & 1) << 8); }
constexpr int v_rd_off(int d0, int ks, int half) { return d0 * 512 + ks * 4096 + half * 2048; }
template <int OFF> DI s16x4 tr_read(int vb) {
  s16x4 r; asm volatile("ds_read_b64_tr_b16 %0, %1 offset:%2" : "=&v"(r) : "v"(vb), "i"(OFF) : "memory"); return r;
}
template <int D0> DI void pv_one(f32x16& od, int vb, bf16x8 pa0, bf16x8 pa1, bf16x8 pa2, bf16x8 pa3) {
  const s16x4 l0 = tr_read<v_rd_off(D0, 0, 0)>(vb), h0 = tr_read<v_rd_off(D0, 0, 1)>(vb), l1 = tr_read<v_rd_off(D0, 1, 0)>(vb), h1 = tr_read<v_rd_off(D0, 1, 1)>(vb);
  const s16x4 l2 = tr_read<v_rd_off(D0, 2, 0)>(vb), h2 = tr_read<v_rd_off(D0, 2, 1)>(vb), l3 = tr_read<v_rd_off(D0, 3, 0)>(vb), h3 = tr_read<v_rd_off(D0, 3, 1)>(vb);
  asm volatile("s_waitcnt lgkmcnt(0)" ::: "memory"); SBAR();
#define PK(L, H) (bf16x8){L[0], L[1], L[2], L[3], H[0], H[1], H[2], H[3]}
  od = __builtin_amdgcn_mfma_f32_32x32x16_bf16(pa0, PK(l0, h0), od, 0, 0, 0);
  od = __builtin_amdgcn_mfma_f32_32x32x16_bf16(pa1, PK(l1, h1), od, 0, 0, 0);
  od = __builtin_amdgcn_mfma_f32_32x32x16_bf16(pa2, PK(l2, h2), od, 0, 0, 0);
  od = __builtin_amdgcn_mfma_f32_32x32x16_bf16(pa3, PK(l3, h3), od, 0, 0, 0);
#undef PK
}
DI void pv_d0(f32x16* o, int vb, bf16x8 pa0, bf16x8 pa1, bf16x8 pa2, bf16x8 pa3) {
  pv_one<0>(o[0], vb, pa0, pa1, pa2, pa3); pv_one<1>(o[1], vb, pa0, pa1, pa2, pa3); pv_one<2>(o[2], vb, pa0, pa1, pa2, pa3); pv_one<3>(o[3], vb, pa0, pa1, pa2, pa3);
}
DI void attn_dense_body(const bf16_t* Qb, const bf16_t* __restrict__ Kh, const bf16_t* __restrict__ Vh, bf16_t* Ob, int seq, char* lds) {
  const int tid = threadIdx.x, wid = tid >> 6, lane = tid & 63, r32 = lane & 31, hi = lane >> 5;
  bf16_t* V_lds = (bf16_t*)lds; bf16_t* K_lds = (bf16_t*)(lds + 3 * SHM_V);
  float* ws = (float*)(lds + 3 * SHM_V + 3 * SHM_K) + wid * 64; float* li_l = ws; float* al_l = ws + 32;
  float m_reg = -1e30f, l_reg = 0; f32x16 o[4] = {}; bf16x8 qr[6];
  const bf16_t* Qw = Qb + (long)(wid * QBLK + r32) * LDQ + hi * 8;
#pragma unroll
  for (int d0 = 0; d0 < 6; ++d0) qr[d0] = *reinterpret_cast<const bf16x8*>(Qw + d0 * 16);
  const int sr = tid >> 4, sc = (tid & 15) * 8, vst0 = v_st(sr, sc), vst1 = v_st(32 + sr, sc);
  const int kr0 = tid / 12, kc0 = (tid - kr0 * 12) * 8, kr1 = (tid + 512) / 12, kc1 = ((tid + 512) - kr1 * 12) * 8;
  const bool k2 = wid < 4;
  const int kst0 = KSWZ(kr0, kc0 * 2), kst1 = KSWZ(kr1, kc1 * 2);
  const int vb0 = (int)(uintptr_t)V_lds + v_rd_base(lane);
  struct { bf16x8 vs0, vs1, ks0, ks1; } sr_[SDEPTH];
#define SLOAD(i, k0) do { sr_[i].vs0 = *(const bf16x8*)(&Vh[(long)((k0) + sr) * LDKV + sc]); sr_[i].vs1 = *(const bf16x8*)(&Vh[(long)((k0) + 32 + sr) * LDKV + sc]); \
    sr_[i].ks0 = *(const bf16x8*)(&Kh[(long)((k0) + kr0) * LDKK + kc0]); if (k2) sr_[i].ks1 = *(const bf16x8*)(&Kh[(long)((k0) + kr1) * LDKK + kc1]); } while (0)
#define SWRITE(b, i) do { *(bf16x8*)((char*)V_lds + (b) * SHM_V + vst0) = sr_[i].vs0; *(bf16x8*)((char*)V_lds + (b) * SHM_V + vst1) = sr_[i].vs1; \
    *(bf16x8*)((char*)K_lds + (b) * SHM_K + kst0) = sr_[i].ks0; if (k2) *(bf16x8*)((char*)K_lds + (b) * SHM_K + kst1) = sr_[i].ks1; } while (0)
#define SWAIT() do { if (SDEPTH == 2) asm volatile("s_waitcnt vmcnt(4)" ::: "memory"); else asm volatile("s_waitcnt vmcnt(0)" ::: "memory"); } while (0)
#define RESC(a) do { if (__any((a) < 1.f)) { if (hi == 0) al_l[r32] = (a); asm volatile("s_waitcnt lgkmcnt(0)" ::: "memory"); \
    _Pragma("unroll") for (int d = 0; d < 4; ++d) _Pragma("unroll") for (int r = 0; r < 16; ++r) o[d][r] *= al_l[crow(r, hi)]; } } while (0)
  f32x16 pA0, pA1, pB0, pB1; float mnA, mnB, alA, alB; bf16x8 pa0, pa1, pa2, pa3; const int NT = seq / KVBLK;
  constexpr int SE = 0, SO = SDEPTH - 1;
  static_assert(SDEPTH == 1, "the three-buffer loop is written for one tile of register staging");
  SLOAD(SE, 0); asm volatile("s_waitcnt vmcnt(0)" ::: "memory"); SWRITE(0, SE); __syncthreads();
  qkt(pA0, pA1, K_lds, qr, r32, hi); partialSM(pA0, pA1, m_reg, mnA, alA);
  SLOAD(SO, KVBLK);
  SWAIT(); SWRITE(1, SO); __syncthreads();
  int prv = 0, cur = 1, nxt = 2;
#define ROT3() do { const int t_ = prv; prv = cur; cur = nxt; nxt = t_; } while (0)
  for (int j = 1; j + 1 < NT; j += 2) {
    SBAR(); qkt(pB0, pB1, (bf16_t*)((char*)K_lds + cur * SHM_K), qr, r32, hi);
    finishSM(pA0, pA1, alA, l_reg, pa0, pa1, pa2, pa3); SBAR();
    SLOAD(SO, (j + 1) * KVBLK); SBAR();
    pv_d0(o, vb0 + prv * (int)SHM_V, pa0, pa1, pa2, pa3); partialSM(pB0, pB1, m_reg, mnB, alB);
    SWAIT(); SWRITE(nxt, SE);
    RESC(alB); __syncthreads(); ROT3();
    SBAR(); qkt(pA0, pA1, (bf16_t*)((char*)K_lds + cur * SHM_K), qr, r32, hi);
    finishSM(pB0, pB1, alB, l_reg, pa0, pa1, pa2, pa3); SBAR();
    SLOAD(SE, (j + 2) * KVBLK); SBAR();
    pv_d0(o, vb0 + prv * (int)SHM_V, pa0, pa1, pa2, pa3); partialSM(pA0, pA1, m_reg, mnA, alA);
    SWAIT(); SWRITE(nxt, SO);
    RESC(alA); __syncthreads(); ROT3();
  }
  SBAR(); qkt(pB0, pB1, (bf16_t*)((char*)K_lds + cur * SHM_K), qr, r32, hi);
  finishSM(pA0, pA1, alA, l_reg, pa0, pa1, pa2, pa3); SBAR();
  pv_d0(o, vb0 + prv * (int)SHM_V, pa0, pa1, pa2, pa3); partialSM(pB0, pB1, m_reg, mnB, alB);
  RESC(alB);
  finishSM(pB0, pB1, alB, l_reg, pa0, pa1, pa2, pa3); SBAR();
  pv_d0(o, vb0 + cur * (int)SHM_V, pa0, pa1, pa2, pa3);
#undef ROT3
  if (hi == 0) li_l[r32] = l_reg; asm volatile("s_waitcnt lgkmcnt(0)" ::: "memory");
  float rli[16];
#pragma unroll
  for (int r = 0; r < 16; ++r) rli[r] = __builtin_amdgcn_rcpf(li_l[crow(r, hi)]);
  bf16_t* Ow = Ob + (long)(wid * QBLK) * LDQ;
#pragma unroll
  for (int r = 0; r < 16; ++r) { const int orow = crow(r, hi);
#pragma unroll
    for (int d0 = 0; d0 < 4; ++d0) Ow[(long)orow * LDQ + d0 * 32 + r32] = (bf16_t)(cvt_pk_bf16(o[d0][r] * rli[r], 0.f) & 0xffffu); }
  __syncthreads();
#undef SLOAD
#undef SWRITE
#undef SWAIT
#undef RESC
}
}

namespace gla {
constexpr int QD_OFF = 0, KD_OFF = 17408, KE_OFF = 34816, VV_OFF = 51200, PP_OFF = 83968, DD_OFF = 93184, QROW = 272, PROW = 144;
#define GLA_BAR() do { asm volatile("s_waitcnt lgkmcnt(0)" ::: "memory"); __builtin_amdgcn_s_barrier(); asm volatile("" ::: "memory"); } while (0)
#define MFMA32(a, b, c) __builtin_amdgcn_mfma_f32_32x32x16_bf16((a), (b), (c), 0, 0, 0)
DI bf16x8 pack_step(const f32x16& x, int s) {
    u32x4 p; p.x = cvt_pk_bf16(x[8 * s], x[8 * s + 1]); p.y = cvt_pk_bf16(x[8 * s + 2], x[8 * s + 3]); p.z = cvt_pk_bf16(x[8 * s + 4], x[8 * s + 5]); p.w = cvt_pk_bf16(x[8 * s + 6], x[8 * s + 7]);
    return __builtin_bit_cast(bf16x8, p);
}
template <int DIR> DI void unit(int b, int h, const bf16_t* __restrict__ gqkv, const _Float16* __restrict__ bc, bf16_t* __restrict__ oo, char* lds) {
    using att::v_st; using att::v_rd_base; using att::v_rd_off; using att::tr_read; using att::crow;
    const int tid = threadIdx.x, lane = tid & 63, wid = tid >> 6, r32 = lane & 31, hi = lane >> 5, fr = lane & 15, fq = lane >> 4;
    const int t = tid >> 3, g = tid & 7, sr = tid >> 4, sc = (tid & 15) * 8;
    char* QD = lds + QD_OFF; char* KD = lds + KD_OFF; char* KE = lds + KE_OFF; char* VV = lds + VV_OFF; char* PP = lds + PP_OFF; float* DD = (float*)(lds + DD_OFF);
    const int vst0 = v_st(sr, sc), vst1 = v_st(32 + sr, sc), kst0 = v_st(t, 16 * g), kst1 = v_st(t, 16 * g + 8);
    const int vb = (int)(uintptr_t)VV + (wid >> 2) * 16384 + (wid & 3) * 512 + v_rd_base(lane), keb = (int)(uintptr_t)KE + v_rd_base(lane);
    f32x16 st[4] = {};
    u32x4 q0, q1, k0, k1; f16x8 b0, b1, l0, l1; bf16x8 vs0, vs1, vs2, vs3;
#define GLOAD(ci_) do { const int chunk_ = DIR ? 63 - (ci_) : (ci_); const long row0_ = (long)b * SEQ + chunk_ * 64; \
        const bf16_t* qp_ = gqkv + (row0_ + t) * 2048 + h * 128 + g * 16; q0 = *(const u32x4*)qp_; q1 = *(const u32x4*)(qp_ + 8); k0 = *(const u32x4*)(qp_ + 512); k1 = *(const u32x4*)(qp_ + 520); \
        const _Float16* bp_ = bc + (row0_ + t) * 512 + h * 128 + g * 16; b0 = *(const f16x8*)bp_; b1 = *(const f16x8*)(bp_ + 8); \
        const _Float16* lp_ = bc + (row0_ + (DIR ? 0 : 63)) * 512 + h * 128 + g * 16; l0 = *(const f16x8*)lp_; l1 = *(const f16x8*)(lp_ + 8); \
        const bf16_t* vp_ = gqkv + (row0_ + sr) * 2048 + 1024 + h * 256 + sc; vs0 = *(const bf16x8*)vp_; vs1 = *(const bf16x8*)(vp_ + 128); vs2 = *(const bf16x8*)(vp_ + 32 * 2048); vs3 = *(const bf16x8*)(vp_ + 32 * 2048 + 128); } while (0)
    GLOAD(0);
    for (int ci = 0; ci < 64; ++ci) {
        const int chunk = DIR ? 63 - ci : ci; const long row0 = (long)b * SEQ + chunk * 64;
        { float qf[16], kf[16]; unpack8(q0, qf); unpack8(q1, qf + 8); unpack8(k0, kf); unpack8(k1, kf + 8);
          float qd[16], kd[16], ke[16], dl[16];
#pragma unroll
          for (int j = 0; j < 16; ++j) { const float bb = (float)(j < 8 ? b0[j & 7] : b1[j & 7]), ll = (float)(j < 8 ? l0[j & 7] : l1[j & 7]);
              qd[j] = qf[j] * GLA_QSCALE * __builtin_amdgcn_exp2f(bb); kd[j] = kf[j] * __builtin_amdgcn_exp2f(-bb); ke[j] = kf[j] * __builtin_amdgcn_exp2f(ll - bb); dl[j] = __builtin_amdgcn_exp2f(ll); }
          u32x4 w;
          w.x = cvt_pk_bf16(qd[0], qd[1]); w.y = cvt_pk_bf16(qd[2], qd[3]); w.z = cvt_pk_bf16(qd[4], qd[5]); w.w = cvt_pk_bf16(qd[6], qd[7]); *(u32x4*)(QD + t * QROW + g * 32) = w;
          w.x = cvt_pk_bf16(qd[8], qd[9]); w.y = cvt_pk_bf16(qd[10], qd[11]); w.z = cvt_pk_bf16(qd[12], qd[13]); w.w = cvt_pk_bf16(qd[14], qd[15]); *(u32x4*)(QD + t * QROW + g * 32 + 16) = w;
          w.x = cvt_pk_bf16(kd[0], kd[1]); w.y = cvt_pk_bf16(kd[2], kd[3]); w.z = cvt_pk_bf16(kd[4], kd[5]); w.w = cvt_pk_bf16(kd[6], kd[7]); *(u32x4*)(KD + t * QROW + g * 32) = w;
          w.x = cvt_pk_bf16(kd[8], kd[9]); w.y = cvt_pk_bf16(kd[10], kd[11]); w.z = cvt_pk_bf16(kd[12], kd[13]); w.w = cvt_pk_bf16(kd[14], kd[15]); *(u32x4*)(KD + t * QROW + g * 32 + 16) = w;
          w.x = cvt_pk_bf16(ke[0], ke[1]); w.y = cvt_pk_bf16(ke[2], ke[3]); w.z = cvt_pk_bf16(ke[4], ke[5]); w.w = cvt_pk_bf16(ke[6], ke[7]); *(u32x4*)(KE + kst0) = w;
          w.x = cvt_pk_bf16(ke[8], ke[9]); w.y = cvt_pk_bf16(ke[10], ke[11]); w.z = cvt_pk_bf16(ke[12], ke[13]); w.w = cvt_pk_bf16(ke[14], ke[15]); *(u32x4*)(KE + kst1) = w;
          if (t == (DIR ? 0 : 63)) {
#pragma unroll
              for (int j = 0; j < 16; ++j) DD[16 * g + j] = dl[j]; }
          *(bf16x8*)(VV + vst0) = vs0; *(bf16x8*)(VV + 16384 + vst0) = vs1; *(bf16x8*)(VV + vst1) = vs2; *(bf16x8*)(VV + 16384 + vst1) = vs3; }
        if (ci + 1 < 64) GLOAD(ci + 1);
        GLA_BAR();
        { const int ti = wid >> 1, jb = (wid & 1) * 2; f32x4 s0 = {0.f, 0.f, 0.f, 0.f}, s1 = s0;
#pragma unroll
          for (int ks = 0; ks < 4; ++ks) {
              const bf16x8 af = *(const bf16x8*)(QD + (16 * ti + fr) * QROW + (ks * 32 + fq * 8) * 2);
              const bf16x8 bf0 = *(const bf16x8*)(KD + (16 * jb + fr) * QROW + (ks * 32 + fq * 8) * 2), bf1 = *(const bf16x8*)(KD + (16 * jb + 16 + fr) * QROW + (ks * 32 + fq * 8) * 2);
              s0 = __builtin_amdgcn_mfma_f32_16x16x32_bf16(af, bf0, s0, 0, 0, 0); s1 = __builtin_amdgcn_mfma_f32_16x16x32_bf16(af, bf1, s1, 0, 0, 0); }
#pragma unroll
          for (int r = 0; r < 4; ++r) { const int tt = 16 * ti + 4 * fq + r, c0 = 16 * jb + fr, c1 = c0 + 16;
              const bool keep0 = DIR ? (c0 > tt) : (c0 <= tt), keep1 = DIR ? (c1 > tt) : (c1 <= tt);
              *(bf16_t*)(PP + tt * PROW + c0 * 2) = (bf16_t)(cvt_pk_bf16(keep0 ? s0[r] : 0.f, 0.f) & 0xffffu);
              *(bf16_t*)(PP + tt * PROW + c1 * 2) = (bf16_t)(cvt_pk_bf16(keep1 ? s1[r] : 0.f, 0.f) & 0xffffu); } }
        GLA_BAR();
        { bf16x8 vf[4];
          { const s16x4 a0 = tr_read<v_rd_off(0, 0, 0)>(vb), c0 = tr_read<v_rd_off(0, 0, 1)>(vb), a1 = tr_read<v_rd_off(0, 1, 0)>(vb), c1 = tr_read<v_rd_off(0, 1, 1)>(vb);
            const s16x4 a2 = tr_read<v_rd_off(0, 2, 0)>(vb), c2 = tr_read<v_rd_off(0, 2, 1)>(vb), a3 = tr_read<v_rd_off(0, 3, 0)>(vb), c3 = tr_read<v_rd_off(0, 3, 1)>(vb);
            asm volatile("s_waitcnt lgkmcnt(0)" ::: "memory"); __builtin_amdgcn_sched_barrier(0);
#define PKV(L, H) (bf16x8){L[0], L[1], L[2], L[3], H[0], H[1], H[2], H[3]}
            vf[0] = PKV(a0, c0); vf[1] = PKV(a1, c1); vf[2] = PKV(a2, c2); vf[3] = PKV(a3, c3); }
          f32x16 o0 = {}, o1 = {};
#pragma unroll
          for (int ks = 0; ks < 4; ++ks) {
              const bf16x8 pa0 = *(const bf16x8*)(PP + r32 * PROW + (16 * ks + 8 * hi) * 2), pa1 = *(const bf16x8*)(PP + (32 + r32) * PROW + (16 * ks + 8 * hi) * 2);
              o0 = MFMA32(pa0, vf[ks], o0); o1 = MFMA32(pa1, vf[ks], o1); }
#pragma unroll
          for (int ti = 0; ti < 4; ++ti)
#pragma unroll
              for (int s = 0; s < 2; ++s) {
                  const bf16x8 sb = pack_step(st[ti], s);
                  const char* qa = QD + r32 * QROW + (32 * ti + 16 * s + 4 * hi) * 2;
                  const s16x4 x0 = *(const s16x4*)qa, x1 = *(const s16x4*)(qa + 16), y0 = *(const s16x4*)(qa + 32 * QROW), y1 = *(const s16x4*)(qa + 32 * QROW + 16);
                  o0 = MFMA32(PKV(x0, x1), sb, o0); o1 = MFMA32(PKV(y0, y1), sb, o1); }
          bf16_t* op = oo + (row0) * 1024 + h * 256 + wid * 32 + r32;
#pragma unroll
          for (int r = 0; r < 16; ++r) { const int tr = crow(r, hi);
              op[(long)tr * 1024] = (bf16_t)(cvt_pk_bf16(o0[r], 0.f) & 0xffffu); op[(long)(32 + tr) * 1024] = (bf16_t)(cvt_pk_bf16(o1[r], 0.f) & 0xffffu); }
#define KE_TILE(TI) do { \
              const s16x4 a0 = tr_read<v_rd_off(TI, 0, 0)>(keb), c0 = tr_read<v_rd_off(TI, 0, 1)>(keb), a1 = tr_read<v_rd_off(TI, 1, 0)>(keb), c1 = tr_read<v_rd_off(TI, 1, 1)>(keb); \
              const s16x4 a2 = tr_read<v_rd_off(TI, 2, 0)>(keb), c2 = tr_read<v_rd_off(TI, 2, 1)>(keb), a3 = tr_read<v_rd_off(TI, 3, 0)>(keb), c3 = tr_read<v_rd_off(TI, 3, 1)>(keb); \
              _Pragma("unroll") for (int gq = 0; gq < 4; ++gq) { const f32x4 dv = *(const f32x4*)(DD + 32 * TI + 8 * gq + 4 * hi); \
                  st[TI][4 * gq] *= dv[0]; st[TI][4 * gq + 1] *= dv[1]; st[TI][4 * gq + 2] *= dv[2]; st[TI][4 * gq + 3] *= dv[3]; } \
              asm volatile("s_waitcnt lgkmcnt(0)" ::: "memory"); __builtin_amdgcn_sched_barrier(0); \
              st[TI] = MFMA32(PKV(a0, c0), vf[0], st[TI]); st[TI] = MFMA32(PKV(a1, c1), vf[1], st[TI]); st[TI] = MFMA32(PKV(a2, c2), vf[2], st[TI]); st[TI] = MFMA32(PKV(a3, c3), vf[3], st[TI]); } while (0)
          KE_TILE(0); KE_TILE(1); KE_TILE(2); KE_TILE(3);
#undef KE_TILE
#undef PKV
        }
        GLA_BAR();
    }
#undef GLOAD
}
}

template <int DIR> DI void gla_naive_unit(int b, int h, const bf16_t* gqkv, const _Float16* bc, bf16_t* oo, unsigned char* ldsg) {
    const int tid = threadIdx.x;
    float* qs = (float*)ldsg; float* ks = qs + 64 * 128; float* as = ks + 64 * 128;
    float s[128];
#pragma unroll
    for (int i = 0; i < 128; ++i) s[i] = 0.f;
    for (int ci = 0; ci < 64; ++ci) {
        const int chunk = DIR ? 63 - ci : ci; const long row0 = (long)b * SEQ + chunk * 64;
        __syncthreads();
        { const int t = tid >> 3, g = tid & 7; const long row = row0 + t;
          const bf16_t* qp = gqkv + row * 2048 + h * 128 + g * 16; const bf16_t* kp = qp + 512;
          const int tp = DIR ? t + 1 : t - 1; const bool hasp = DIR ? (t < 63) : (t > 0);
          const _Float16* bp = bc + row * 512 + h * 128 + g * 16; const _Float16* bpp = bc + (row0 + (hasp ? tp : t)) * 512 + h * 128 + g * 16;
          float qf[16], kf[16];
          unpack8(*(const u32x4*)qp, qf); unpack8(*(const u32x4*)(qp + 8), qf + 8); unpack8(*(const u32x4*)kp, kf); unpack8(*(const u32x4*)(kp + 8), kf + 8);
          const f16x8 b0 = *(const f16x8*)bp, b1 = *(const f16x8*)(bp + 8), c0 = *(const f16x8*)bpp, c1 = *(const f16x8*)(bpp + 8);
#pragma unroll
          for (int j = 0; j < 16; ++j) {
              const float bb = (float)(j < 8 ? b0[j & 7] : b1[j & 7]), cc = hasp ? (float)(j < 8 ? c0[j & 7] : c1[j & 7]) : 0.f;
              qs[t * 128 + g * 16 + j] = qf[j] * GLA_QSCALE; ks[t * 128 + g * 16 + j] = kf[j]; as[t * 128 + g * 16 + j] = exp2f(bb - cc);
          } }
        __syncthreads();
        if (tid < 256) {
            for (int tt = 0; tt < 64; ++tt) {
                const int t = DIR ? 63 - tt : tt; const long row = row0 + t;
                const float v = bf2f(gqkv[row * 2048 + 1024 + h * 256 + tid]);
                float o = 0.f;
                const f32x4* q4 = (const f32x4*)(qs + t * 128); const f32x4* k4 = (const f32x4*)(ks + t * 128); const f32x4* a4 = (const f32x4*)(as + t * 128);
#pragma unroll
                for (int d4 = 0; d4 < 32; ++d4) { const f32x4 q = q4[d4], k = k4[d4], a = a4[d4];
#pragma unroll
                    for (int e = 0; e < 4; ++e) {
                        if (DIR == 0) { s[4 * d4 + e] = fmaf(s[4 * d4 + e], a[e], k[e] * v); o = fmaf(q[e], s[4 * d4 + e], o); }
                        else { const float sd = s[4 * d4 + e] * a[e]; o = fmaf(q[e], sd, o); s[4 * d4 + e] = fmaf(k[e], v, sd); } }
                    if ((d4 & 3) == 3) asm volatile("" ::: "memory"); }
                oo[row * 1024 + h * 256 + tid] = (bf16_t)(cvt_pk_bf16(o, 0.f) & 0xffffu);
            }
        }
    }
    __syncthreads();
}

DI void tr_item(const float* W, int ldw, int col0, int K, bf16_t* WT, int drow0, const float* gs, LAS float* scr, int item, int nblk, int lane, int ldt = 0) {
    if (ldt == 0) ldt = K;
    const int kb = item / nblk, nb = item - kb * nblk, k0 = 64 * kb, n0 = 32 * nb;
#pragma unroll
    for (int i = 0; i < 32; ++i) { const int kk = 2 * i + (lane >> 5); float w = W[(size_t)(k0 + kk) * ldw + col0 + n0 + (lane & 31)]; if (gs) w *= gs[k0 + kk]; scr[kk * 33 + (lane & 31)] = w; }
    LDS_WAIT(); asm volatile("" ::: "memory");
    const int c = lane & 7;
#pragma unroll
    for (int j = 0; j < 4; ++j) { const int n = (lane >> 3) + 8 * j; const LAS float* s = scr + (8 * c) * 33 + n;
        u32x4 o; o.x = cvt_pk_bf16(s[0 * 33], s[1 * 33]); o.y = cvt_pk_bf16(s[2 * 33], s[3 * 33]); o.z = cvt_pk_bf16(s[4 * 33], s[5 * 33]); o.w = cvt_pk_bf16(s[6 * 33], s[7 * 33]);
        const int ng = drow0 + n0 + n;
        if (ldt > 0) *(u32x4*)(WT + (size_t)ng * ldt + k0 + 8 * c) = o;
        else *(u32x4*)(WT + (((size_t)(ng >> 8) * (size_t)(-ldt) + kb) * 256 + (ng & 255)) * 64 + 8 * c) = o; }
    LDS_WAIT(); asm volatile("" ::: "memory");
}
DI float logsigmoidf_(float x) { return fminf(x, 0.f) - log1pf(expf(-fabsf(x))); }

#define XB_TMO      128
#define XB_XCNT(j)  (256  + 64 * (j))
#define XB_XSUB(j)  (1280 + 64 * (j))
#define XB_XGEN(j)  (2304 + 64 * (j))
#define XB_TOP      3328
#define XB_TOPGEN   3392
#define XCD_BAR_WORDS 3456
#define XB_SPIN_CAP (1u << 18)

__device__ __forceinline__ unsigned xb_ld(unsigned* p)              { return __hip_atomic_load(p, __ATOMIC_RELAXED, __HIP_MEMORY_SCOPE_AGENT); }
__device__ __forceinline__ unsigned xb_add(unsigned* p, unsigned v) { return __hip_atomic_fetch_add(p, v, __ATOMIC_RELAXED, __HIP_MEMORY_SCOPE_AGENT); }
__device__ __forceinline__ unsigned xb_xcc_id() { return (unsigned)__builtin_amdgcn_s_getreg((3 << 11) | 20) & 0xFu; }
#define XB_SPIN(cond, bar) do { unsigned _sp = 0; while (cond) { __builtin_amdgcn_s_sleep(1); \
    if ((++_sp & 255u) == 0u) { if (xb_ld(&(bar)[XB_TMO])) break; if (_sp > XB_SPIN_CAP) { atomicAdd(&(bar)[XB_TMO], 1u); break; } } } } while (0)

struct XcdBarrier {
    unsigned* bar; unsigned x;
    volatile LAS unsigned* st;
};

__device__ __forceinline__ XcdBarrier xcd_barrier_post(unsigned* bar, volatile LAS unsigned* st) {
    XcdBarrier b; b.bar = bar; b.x = xb_xcc_id(); b.st = st;
    if (threadIdx.x == 0) (void)xb_add(&bar[XB_XCNT(b.x)], 1u);
    return b;
}
__device__ __forceinline__ void xcd_barrier_complete(unsigned* bar, unsigned x, unsigned& nloc, unsigned& nx) {
    const unsigned G = gridDim.x * gridDim.y * gridDim.z;
    unsigned sum, cnt, mine, sp = 0u;
    for (;;) {
        sum = 0u; cnt = 0u; mine = 0u;
#pragma unroll
        for (unsigned j = 0; j < 16; ++j) { const unsigned c = xb_ld(&bar[XB_XCNT(j)]); sum += c; cnt += (c > 0u) ? 1u : 0u; mine = (j == x) ? c : mine; }
        if (sum == G) break;
        __builtin_amdgcn_s_sleep(1);
        if ((++sp & 255u) == 0u) { if (xb_ld(&bar[XB_TMO])) break; if (sp > XB_SPIN_CAP) { atomicAdd(&bar[XB_TMO], 1u); break; } }
    }
    nloc = mine > 0u ? mine : 1u; nx = cnt > 0u ? cnt : 1u;
}

__device__ __forceinline__ void xcd_barrier(const XcdBarrier& b) {
    asm volatile("s_waitcnt vmcnt(0)" ::: "memory");
    __syncthreads();
    if (threadIdx.x == 0) {
        unsigned* bar = b.bar;
        __builtin_amdgcn_s_waitcnt(0);
        unsigned nloc = b.st[0], nx = b.st[1];
        if (nloc == 0u) { xcd_barrier_complete(bar, b.x, nloc, nx); b.st[0] = nloc; b.st[1] = nx; }
        const unsigned old = xb_add(&bar[XB_XSUB(b.x)], 1u);
        const unsigned gen = old / nloc;
        if (old + 1u == (gen + 1u) * nloc) {
            __builtin_amdgcn_fence(__ATOMIC_RELEASE, "agent");
            asm volatile("s_waitcnt vmcnt(0)" ::: "memory");
            const unsigned og = xb_add(&bar[XB_TOP], 1u);
            const unsigned tg = og / nx;
            if (og + 1u == (tg + 1u) * nx) xb_add(&bar[XB_TOPGEN], 1u);
            else XB_SPIN(xb_ld(&bar[XB_TOPGEN]) == tg, bar);
            __builtin_amdgcn_fence(__ATOMIC_ACQUIRE, "agent");
            xb_add(&bar[XB_XGEN(b.x)], 1u);
            asm volatile("s_waitcnt vmcnt(0)" ::: "memory");
        } else {
            XB_SPIN(xb_ld(&bar[XB_XGEN(b.x)]) == gen, bar);
            __builtin_amdgcn_fence(__ATOMIC_ACQUIRE, "agent");
            asm volatile("s_waitcnt vmcnt(0)" ::: "memory");
        }
    }
    __syncthreads();
}

constexpr int NPHASE = 10;
__global__ void __launch_bounds__(NTHR, 2) fwd_megakernel(Args a) {
    extern __shared__ __attribute__((aligned(16))) unsigned char lds[];
    cg::grid_group grid = cg::this_grid();
    LAS unsigned char* ldsl = (LAS unsigned char*)lds;
    const int tid = threadIdx.x, lane = tid & 63, wave = __builtin_amdgcn_readfirstlane(tid >> 6);
    const int G = gridDim.x, bid = blockIdx.x;
    const int gw = bid * NWAVES + wave, NGW = G * NWAVES; const long gt = (long)bid * NTHR + tid, NGT = (long)G * NTHR;
#define WSP(T_, off) ((T_*)(a.ws + (off)))
#define WinA WSP(bf16_t, WS_WINA)
#define WinB WSP(bf16_t, WS_WINB)
#define Wuq WSP(bf16_t, WS_WUQ)
#define Wukv WSP(bf16_t, WS_WUKV)
#define Wout WSP(bf16_t, WS_WOUT)
#define W1 WSP(bf16_t, WS_W1)
#define W2 WSP(bf16_t, WS_W2)
#define ropec WSP(float, WS_ROPEC)
#define ropes WSP(float, WS_ROPES)
#define ssq_q WSP(float, WS_SSQ)
#define ssq_kv (WSP(float, WS_SSQ) + T)
#define ssq_h (WSP(float, WS_SSQ) + 2 * T)
#define ssq_h2 (WSP(float, WS_SSQ) + 3 * T)
#define ctl WSP(int, WS_CTL)
#define XN WSP(bf16_t, WS_XN)
#define MERGED WSP(bf16_t, WS_MERGED)
#define GQKV WSP(bf16_t, WS_GQKV)
#define KB WSP(bf16_t, WS_K)
#define VB WSP(bf16_t, WS_V)
#define GATES WSP(bf16_t, WS_GATES)
#define UB WSP(bf16_t, WS_U)
#define QO WSP(bf16_t, WS_QO)
#define SMALL WSP(bf16_t, WS_SMALL)
#define OB WSP(bf16_t, WS_OB)
#define HB WSP(bf16_t, WS_HB)
#define BCF ((_Float16*)a.out)
#define BCB ((_Float16*)a.out + (size_t)T * 512)
#define OF ((bf16_t*)((unsigned char*)a.out + 64 * MiB))
    const int lo = a.ph_lo, hi_ = a.ph_hi;
    LAS int* misc = (LAS int*)(ldsl + LDS_MISC);
    if (tid == 0) { const int x = (int)(__builtin_amdgcn_s_getreg((3 << 11) | 20) & 0xFu); misc[0] = x; misc[1] = atomicAdd(ctl + 16 + x, 1); }
    if (tid == 0) { misc[8] = 0; misc[9] = 0; }
    __syncthreads();
    int cvirt = bid;
    const XcdBarrier xbar = xcd_barrier_post((unsigned*)(ctl + 1024), (volatile LAS unsigned*)(misc + 8));
#ifndef DBG_MASK
#define DBG_MASK 0x3ff
#endif
#define IN(k) (lo <= (k) && (k) < hi_ && ((DBG_MASK >> (k)) & 1))
#define SEAM(k) do { if (IN(k) && IN((k) + 1)) xcd_barrier(xbar); } while (0)

    if (IN(0)) {
        LAS float* scr = (LAS float*)(ldsl + wave * 16384);
        constexpr int J0 = 16 * 64, J1 = 16 * 22, J4 = 6 * 24, J5 = 4 * 48;
        constexpr int NITEMS = J0 + J1 + J4 + J5;
        for (int it = gw; it < NITEMS; it += NGW) {
            int r = it;
            if (r < J0) { tr_item(a.w_in, 5824, 0, 1024, WinA, 0, nullptr, scr, r, 64, lane); continue; } r -= J0;
            if (r < J1) { tr_item(a.w_in, 5824, 3072, 1024, WinA, 2048, nullptr, scr, r, 22, lane); continue; } r -= J1;
            if (r < J4) { tr_item(a.w_uq, 768, 0, 384, Wuq, 0, a.g_q, scr, r, 24, lane); continue; } r -= J4;
            tr_item(a.w_ukv, 1536, 0, 256, Wukv, 0, a.g_kv, scr, r, 48, lane);
        }
        for (long i = gt; i < 64 * 1024 / 8; i += NGT) *(u32x4*)(WinA + (size_t)2752 * 1024 + i * 8) = (u32x4){0u, 0u, 0u, 0u};
        for (int m0 = gw; m0 < T; m0 += 4 * NGW) {
            const f32x4* gr = (const f32x4*)a.g_mix + lane; f32x4 v[4][4];
#pragma unroll
            for (int k = 0; k < 4; ++k) { const int m = m0 + k * NGW; if (m < T) { const f32x4* xr = (const f32x4*)(a.x + (size_t)m * DM) + lane;
#pragma unroll
                for (int j = 0; j < 4; ++j) v[k][j] = xr[64 * j]; } }
#pragma unroll
            for (int k = 0; k < 4; ++k) { const int m = m0 + k * NGW; if (m < T) { float s2 = 0.f;
#pragma unroll
                for (int j = 0; j < 4; ++j) s2 += (v[k][j].x * v[k][j].x + v[k][j].y * v[k][j].y) + (v[k][j].z * v[k][j].z + v[k][j].w * v[k][j].w);
                const float rstd = rsqrtf(wave_sum(s2) * (1.f / DM) + EPS);
                u32x2* o8 = (u32x2*)(XN + (size_t)m * DM) + lane;
#pragma unroll
                for (int j = 0; j < 4; ++j) { const f32x4 g = gr[64 * j]; const f32x4 w = v[k][j] * rstd * g; u32x2 p; p.x = cvt_pk_bf16(w.x, w.y); p.y = cvt_pk_bf16(w.z, w.w); o8[64 * j] = p; } } }
        }
        for (long i = gt; i < (long)T * 16; i += NGT) {
            const int t = (int)(i >> 4), k = (int)(i & 15);
            const float inv = exp2f(-(float)k * (13.287712379549449f / 16.0f)); const float ang = (float)a.pos[t] * inv;
            float sn, cs; sincosf(ang, &sn, &cs); ropec[i] = cs; ropes[i] = sn;
        }
        for (long i = gt; i < (long)T * 4; i += NGT) ssq_q[i] = 0.f;
    }
    SEAM(0);
    if (IN(0) && IN(1) && (G & 7) == 0) {
        bool ok = misc[0] < 8;
#pragma unroll
        for (int j = 0; j < 8; ++j) ok = ok && (__hip_atomic_load(ctl + 16 + j, __ATOMIC_RELAXED, __HIP_MEMORY_SCOPE_AGENT) == (G >> 3));
        if (ok) cvirt = misc[1] * 8 + misc[0];
    }
    if (IN(1)) {
        pg8::Gemm g{XN, WinA, T, NA, DM, DM, DM}; pg8::StaticOrder S; S.init(T, NA, G, cvirt);
        EpiP1a E{GQKV, SMALL, ssq_q, ssq_kv};
        pg8::gemm_phase<EpiP1a, pg8::StaticOrder, true, true>(ldsl, g, S, E);
    }
    SEAM(1);
    if (IN(2)) {
#ifndef DBG_P2
#define DBG_P2 15
#endif
        { pg8::Gemm g{SMALL + 32, Wuq, T, 768, 384, LDSM, 384}; pg8::StaticOrder S; S.init(T, 768, G, cvirt);
          EpiQ E{QO, ssq_q, ropec, ropes};
          pg8::gemm_phase<EpiQ, pg8::StaticOrder, true, true>(ldsl, g, S, E); }
        { pg8::Gemm g{SMALL + 416, Wukv, T, 1536, 256, LDSM, 256}; pg8::StaticOrder S; S.init(T, 1536, G, cvirt);
          EpiKV E{KB, VB, ssq_kv};
          pg8::gemm_phase<EpiKV, pg8::StaticOrder, true, true>(ldsl, g, S, E); }
        for (long i = gt; i < (long)T * 8; i += NGT) {
            const long t = i >> 3; const int h = (int)(i & 7);
            float x[32], c[16], sn[16];
            const bf16_t* kp = SMALL + t * LDSM + 672;
            unpack8(*(const u32x4*)kp, x); unpack8(*(const u32x4*)(kp + 8), x + 8); unpack8(*(const u32x4*)(kp + 16), x + 16); unpack8(*(const u32x4*)(kp + 24), x + 24);
#pragma unroll
            for (int q = 0; q < 4; ++q) { const f32x4 cv = *(const f32x4*)(ropec + t * 16 + 4 * q), sv = *(const f32x4*)(ropes + t * 16 + 4 * q);
                c[4 * q] = cv[0]; c[4 * q + 1] = cv[1]; c[4 * q + 2] = cv[2]; c[4 * q + 3] = cv[3]; sn[4 * q] = sv[0]; sn[4 * q + 1] = sv[1]; sn[4 * q + 2] = sv[2]; sn[4 * q + 3] = sv[3]; }
            float o[32];
#pragma unroll
            for (int k = 0; k < 16; ++k) { o[k] = x[k] * c[k] - x[16 + k] * sn[k]; o[16 + k] = x[k] * sn[k] + x[16 + k] * c[k]; }
            bf16_t* dst = KB + t * 768 + h * 96 + 64;
#pragma unroll
            for (int q = 0; q < 4; ++q) { u32x4 w; w.x = cvt_pk_bf16(o[8 * q], o[8 * q + 1]); w.y = cvt_pk_bf16(o[8 * q + 2], o[8 * q + 3]); w.z = cvt_pk_bf16(o[8 * q + 4], o[8 * q + 5]); w.w = cvt_pk_bf16(o[8 * q + 6], o[8 * q + 7]);
                *(u32x4*)(dst + 8 * q) = w; }
        }
        for (int unit = bid; unit < T / 64; unit += G) {
            float* zs = (float*)lds; const long row0 = (long)unit * 64;
            __syncthreads();
            { const int t = tid >> 3, c4 = (tid & 7) * 4; const u32x2 w = *(const u32x2*)(SMALL + (row0 + t) * LDSM + c4);
              zs[t * 32 + c4] = bflo(w.x); zs[t * 32 + c4 + 1] = bfhi(w.x); zs[t * 32 + c4 + 2] = bflo(w.y); zs[t * 32 + c4 + 3] = bfhi(w.y); }
            __syncthreads();
            float wf[16], wb[16];
#pragma unroll
            for (int r = 0; r < 16; ++r) { wf[r] = a.w_gate_f[r * 512 + tid]; wb[r] = a.w_gate_b[r * 512 + tid]; }
            const float bf_ = a.b_gate_f[tid], bb_ = a.b_gate_b[tid];
            float run = 0.f;
            for (int t = 0; t < 64; ++t) { float pre = bf_;
#pragma unroll
                for (int r = 0; r < 16; ++r) pre = fmaf(zs[t * 32 + r], wf[r], pre);
                run += logsig2_(pre) * (1.0f / 16.0f); BCF[(row0 + t) * 512 + tid] = (_Float16)run; }
            run = 0.f;
            for (int t = 63; t >= 0; --t) { float pre = bb_;
#pragma unroll
                for (int r = 0; r < 16; ++r) pre = fmaf(zs[t * 32 + 16 + r], wb[r], pre);
                run += logsig2_(pre) * (1.0f / 16.0f); BCB[(row0 + t) * 512 + tid] = (_Float16)run; }
        }
        __syncthreads();
    }
    SEAM(2);
    if (IN(3)) {
        LAS int* sidx = (LAS int*)(ldsl + LDS_MISC + 64);
#define FETCH(dst) do { __syncthreads(); if (tid == 0) *sidx = atomicAdd(ctl, 1); __syncthreads(); dst = *sidx; } while (0)
        int idx; FETCH(idx);
#ifndef DBG_NOGLA
        while (idx < 64) {
            const int b = idx >> 3, h = (idx >> 1) & 3;
#ifdef GLA_NAIVE
            if (idx & 1) gla_naive_unit<1>(b, h, GQKV, BCB, OB, lds); else gla_naive_unit<0>(b, h, GQKV, BCF, OF, lds);
#else
            if (idx & 1) gla::unit<1>(b, h, GQKV, BCB, OB, (char*)lds); else gla::unit<0>(b, h, GQKV, BCF, OF, (char*)lds);
#endif
            FETCH(idx);
        }
#endif
#ifndef DBG_NOATT
        while (idx < 64 + 1024) {
            const int u = idx - 64, bh = u >> 4, qb = u & 15, b = bh >> 3, h = bh & 7;
            const size_t rowq = (size_t)b * SEQ + qb * 256, rowk = (size_t)b * SEQ;
            att::attn_dense_body(QO + rowq * 1024 + h * 128, KB + rowk * 768 + h * 96, VB + rowk * 1024 + h * 128, QO + rowq * 1024 + h * 128, SEQ, (char*)lds);
            FETCH(idx);
        }
#endif
        {
            constexpr int J2 = 16 * 32, J3 = 16 * 64, J6 = 16 * 32, J7 = 16 * 128, J8 = 64 * 32, NLATE = J2 + J3 + J6 + J7 + J8, NFILL = NLATE / 16;
            static_assert(NLATE % 16 == 0, "filler units are 16 items each");
            LAS float* scr = (LAS float*)(ldsl + wave * 16384);
            while (idx < 64 + 1024 + NFILL) {
                const int base = (idx - (64 + 1024)) * 16 + wave * 2;
                for (int q = 0; q < 2; ++q) {
                    int r = base + q;
                    if (r < J2) { tr_item(a.w_in, 5824, 2048, 1024, WinB, 0, nullptr, scr, r, 32, lane); continue; } r -= J2;
                    if (r < J3) { tr_item(a.w_in, 5824, 3776, 1024, WinB, 1024, nullptr, scr, r, 64, lane); continue; } r -= J3;
                    if (r < J6) { tr_item(a.w_out, 1024, 0, 1024, Wout, 0, nullptr, scr, r, 32, lane); continue; } r -= J6;
                    if (r < J7) { tr_item(a.w_ff1, 4096, 0, 1024, W1, 0, a.g_mlp, scr, r, 128, lane); continue; } r -= J7;
                    tr_item(a.w_ff2, 1024, 0, 4096, W2, 0, nullptr, scr, r, 32, lane, -(DFF / 64));
                }
                FETCH(idx);
            }
        }
#undef FETCH
    }
    SEAM(3);
    if (IN(4)) {
        pg8::Gemm g{XN, WinB, T, NG, DM, DM, DM}; pg8::StaticOrder S; S.init(T, NG, G, cvirt);
        EpiGates E{GATES};
        pg8::gemm_phase<EpiGates, pg8::StaticOrder, true, true>(ldsl, g, S, E);
    }
    SEAM(4);
    if (IN(5)) {
        for (int m0 = gw; m0 < T; m0 += 2 * NGW) {
            u32x4 ld[2][12];
#pragma unroll
            for (int k = 0; k < 2; ++k) { const int m = m0 + k * NGW; if (m < T) { const size_t r1 = (size_t)m * 1024 + lane * 8; const bf16_t* gp = GATES + (size_t)m * NG + lane * 8;
#pragma unroll
                for (int j = 0; j < 2; ++j) { ld[k][6 * j + 0] = *(const u32x4*)(OF + r1 + 512 * j); ld[k][6 * j + 1] = *(const u32x4*)(OB + r1 + 512 * j); ld[k][6 * j + 2] = *(const u32x4*)(QO + r1 + 512 * j);
                    ld[k][6 * j + 3] = *(const u32x4*)(gp + 512 * j); ld[k][6 * j + 4] = *(const u32x4*)(gp + 1024 + 512 * j); ld[k][6 * j + 5] = *(const u32x4*)(gp + 2048 + 512 * j); } } }
            f32x4 gg[2][2];
#pragma unroll
            for (int j = 0; j < 2; ++j) { gg[j][0] = *(const f32x4*)(a.g_gla + lane * 8 + 512 * j); gg[j][1] = *(const f32x4*)(a.g_gla + lane * 8 + 512 * j + 4); }
#pragma unroll
            for (int k = 0; k < 2; ++k) { const int m = m0 + k * NGW; if (m < T) { const size_t r1 = (size_t)m * 1024 + lane * 8;
#pragma unroll
                for (int j = 0; j < 2; ++j) {
                    float of[8], ob[8], ym[8], gr[8], za[8], zb[8];
                    unpack8(ld[k][6 * j + 0], of); unpack8(ld[k][6 * j + 1], ob); unpack8(ld[k][6 * j + 2], ym); unpack8(ld[k][6 * j + 3], gr); unpack8(ld[k][6 * j + 4], za); unpack8(ld[k][6 * j + 5], zb);
                    float s2 = 0.f;
#pragma unroll
                    for (int e = 0; e < 8; ++e) { of[e] += ob[e]; s2 += of[e] * of[e]; }
                    s2 += __shfl_xor(s2, 1); s2 += __shfl_xor(s2, 2); s2 += __shfl_xor(s2, 4); s2 += __shfl_xor(s2, 8); s2 += __shfl_xor(s2, 16);
                    const float rstd = rsqrtf(s2 * (1.f / 256.f) + EPS);
                    float res[8];
#pragma unroll
                    for (int e = 0; e < 8; ++e) { const float y = of[e] * rstd * gg[j][e >> 2][e & 3] * gr[e]; res[e] = za[e] * y + zb[e] * ym[e]; }
                    u32x4 w; w.x = cvt_pk_bf16(res[0], res[1]); w.y = cvt_pk_bf16(res[2], res[3]); w.z = cvt_pk_bf16(res[4], res[5]); w.w = cvt_pk_bf16(res[6], res[7]);
                    *(u32x4*)(MERGED + r1 + 512 * j) = w; } } }
        }
    }
    SEAM(5);
    if (IN(6)) {
        pg8::Gemm g{MERGED, Wout, T, DM, DM, DM, DM}; pg8::StaticOrder S; S.init(T, DM, G, cvirt);
        EpiResB<false> E{a.x, HB, ssq_h};
        pg8::gemm_phase<EpiResB<false>, pg8::StaticOrder, true, true>(ldsl, g, S, E);
    }
    SEAM(6);
    if (IN(7)) {
        pg8::Gemm g{HB, W1, T, DFF, DM, DM, DM}; pg8::StaticOrder S; S.init(T, DFF, G, cvirt);
        EpiFF1 E{UB, ssq_h};
        pg8::gemm_phase<EpiFF1, pg8::StaticOrder, true, true>(ldsl, g, S, E);
    }
    SEAM(7);
    if (IN(8)) {
        pg8::Gemm g{UB, W2, T, DM, DFF, 64, 64, 256u * 64u * 2u, (unsigned)(DFF / 64) * 256u * 64u * 2u, 256u * 64u * 2u, (unsigned)(DFF / 64) * 256u * 64u * 2u}; pg8::ReverseOrder S; S.init(T, DM, G, cvirt);
        EpiResB<true> E{HB, MERGED, nullptr};
        pg8::gemm_phase<EpiResB<true>, pg8::ReverseOrder, true, true>(ldsl, g, S, E);
    }
    SEAM(8);
    if (IN(9)) {
        for (int m0 = gw; m0 < T; m0 += 8 * NGW) {
            u32x2 v[8][4];
#pragma unroll
            for (int k = 0; k < 8; ++k) { const int m = m0 + k * NGW; if (m < T) { const u32x2* hp = (const u32x2*)(MERGED + (size_t)m * DM) + lane;
#pragma unroll
                for (int j = 0; j < 4; ++j) v[k][j] = hp[64 * j]; } }
            f32x4 g4[4];
#pragma unroll
            for (int j = 0; j < 4; ++j) g4[j] = ((const f32x4*)a.g_final)[lane + 64 * j];
#pragma unroll
            for (int k = 0; k < 8; ++k) { const int m = m0 + k * NGW; if (m < T) {
                float s2 = 0.f;
#pragma unroll
                for (int j = 0; j < 4; ++j) { const float f0 = bflo(v[k][j].x), f1 = bfhi(v[k][j].x), f2 = bflo(v[k][j].y), f3 = bfhi(v[k][j].y); s2 += (f0 * f0 + f1 * f1) + (f2 * f2 + f3 * f3); }
                const float rstd = rsqrtf(wave_sum(s2) * (1.f / DM) + EPS); f32x4* op = (f32x4*)(a.out + (size_t)m * DM) + lane;
#pragma unroll
                for (int j = 0; j < 4; ++j) __builtin_nontemporal_store((f32x4){bflo(v[k][j].x), bfhi(v[k][j].x), bflo(v[k][j].y), bfhi(v[k][j].y)} * rstd * g4[j], op + 64 * j); } }
        }
    }
    if (a.ph_hi > NPHASE) grid.sync();
#undef IN
#undef SEAM
}

#ifndef MK_PER_PHASE
#define MK_PER_PHASE 0
#endif
extern "C" void kernel_launch(void* const* d_in, const int* in_sizes, int n_in, void* d_out, int out_size, void* d_ws, size_t ws_size, hipStream_t stream) {
    static int grid = 0;
    if (grid == 0) {
        if (n_in != 18 || in_sizes[0] != T * DM || out_size != T * DM || ws_size < WS_END) { fprintf(stderr, "kernel_launch: unexpected shapes (n_in %d in0 %d out %d ws %zu)\n", n_in, n_in > 0 ? in_sizes[0] : -1, out_size, ws_size); grid = -1; return; }
        int dev = 0, cus = 0, per_cu = 0;
        hipGetDevice(&dev); hipDeviceGetAttribute(&cus, hipDeviceAttributeMultiprocessorCount, dev);
        if (hipFuncSetAttribute((const void*)fwd_megakernel, hipFuncAttributeMaxDynamicSharedMemorySize, LDS_BYTES) != hipSuccess) { fprintf(stderr, "kernel_launch: hipFuncSetAttribute failed\n"); grid = -1; return; }
        if (hipOccupancyMaxActiveBlocksPerMultiprocessor(&per_cu, (const void*)fwd_megakernel, NTHR, LDS_BYTES) != hipSuccess || per_cu < 1) { fprintf(stderr, "kernel_launch: occupancy query says %d\n", per_cu); per_cu = 1; }
        (void)hipGetLastError();
        grid = cus * 1;
    }
    if (grid < 0) return;
    if (hipMemsetAsync((char*)d_ws + WS_CTL, 0, 32768, stream) != hipSuccess) { fprintf(stderr, "kernel_launch: memset failed\n"); return; }
    Args a{};
    a.x = (const float*)d_in[0]; a.pos = (const int*)d_in[1]; a.g_mix = (const float*)d_in[2]; a.w_in = (const float*)d_in[3]; a.w_gate_f = (const float*)d_in[4]; a.b_gate_f = (const float*)d_in[5];
    a.w_gate_b = (const float*)d_in[6]; a.b_gate_b = (const float*)d_in[7]; a.g_gla = (const float*)d_in[8]; a.g_q = (const float*)d_in[9]; a.w_uq = (const float*)d_in[10]; a.g_kv = (const float*)d_in[11];
    a.w_ukv = (const float*)d_in[12]; a.w_out = (const float*)d_in[13]; a.g_mlp = (const float*)d_in[14]; a.w_ff1 = (const float*)d_in[15]; a.w_ff2 = (const float*)d_in[16]; a.g_final = (const float*)d_in[17];
    a.out = (float*)d_out; a.ws = (unsigned char*)d_ws;
#if MK_PER_PHASE
    for (int p = 0; p < NPHASE; ++p) { a.ph_lo = p; a.ph_hi = p + 1; hipLaunchKernelGGL(fwd_megakernel, dim3(grid), dim3(NTHR), LDS_BYTES, stream, a); }
#else
    a.ph_lo = 0; a.ph_hi = NPHASE;
    void* args[] = {&a};
    hipError_t e = hipLaunchCooperativeKernel((const void*)fwd_megakernel, dim3(grid), dim3(NTHR), args, LDS_BYTES, stream);
    if (e != hipSuccess) fprintf(stderr, "kernel_launch: cooperative launch failed: %s (grid %d)\n", hipGetErrorString(e), grid);
#endif
}
```

```cpp
#include <hip/hip_runtime.h>
#include <hip/hip_cooperative_groups.h>
#include <cstdio>
#include <cstdint>
namespace cg = cooperative_groups;

typedef unsigned short bf16_t;
typedef short bf16x8 __attribute__((ext_vector_type(8)));
typedef short s16x4 __attribute__((ext_vector_type(4)));
typedef float f32x2 __attribute__((ext_vector_type(2)));
typedef float f32x4 __attribute__((ext_vector_type(4)));
typedef float f32x8 __attribute__((ext_vector_type(8)));
typedef float f32x16 __attribute__((ext_vector_type(16)));
typedef unsigned u32x2 __attribute__((ext_vector_type(2)));
typedef unsigned u32x4 __attribute__((ext_vector_type(4)));
typedef _Float16 f16x8 __attribute__((ext_vector_type(8)));
#define DI __device__ __forceinline__
typedef __bf16 bf16x2_t __attribute__((ext_vector_type(2)));
DI unsigned cvt_pk_bf16(float lo, float hi) { f32x2 v = {lo, hi}; bf16x2_t b = __builtin_convertvector(v, bf16x2_t); return __builtin_bit_cast(unsigned, b); }
DI float bf2f(unsigned short b) { return __uint_as_float((unsigned)b << 16); }
DI float bflo(unsigned w) { return __uint_as_float(w << 16); }
DI float bfhi(unsigned w) { return __uint_as_float(w & 0xffff0000u); }
DI u32x4 pack8(const f32x4 a, const f32x4 b) { u32x4 w; w.x = cvt_pk_bf16(a[0], a[1]); w.y = cvt_pk_bf16(a[2], a[3]); w.z = cvt_pk_bf16(b[0], b[1]); w.w = cvt_pk_bf16(b[2], b[3]); return w; }
DI void unpack8(const u32x4 w, float* f) { f[0] = bflo(w.x); f[1] = bfhi(w.x); f[2] = bflo(w.y); f[3] = bfhi(w.y); f[4] = bflo(w.z); f[5] = bfhi(w.z); f[6] = bflo(w.w); f[7] = bfhi(w.w); }

namespace pg8 {
#define PG8_LAS __attribute__((address_space(3)))
constexpr int BM = 256, BK = 64, HALF = 128, HTB = HALF * BK * 2  , STAGE_BYTES = 8 * HTB, NXCD = 8, WGM = 8;
__host__ __device__ __forceinline__ int lds_byte(int r, int c) { const int st = (r >> 4) * 2 + (c >> 5), rr = r & 15, cc = c & 31, ob = rr * 64 + cc * 2; return st * 1024 + (ob ^ (((ob >> 9) & 1) << 5)); }
__host__ __device__ __forceinline__ void stage_rc(int b, int& R, int& C) { const int st = b / 1024, sb = b % 1024, swz = sb ^ (((sb >> 9) & 1) << 5); R = (st >> 1) * 16 + swz / 64; C = (st & 1) * 32 + (swz % 64) / 2; }
__host__ __device__ __forceinline__ int perm32(int rho) { const int n = rho >> 4, i = rho & 15; return 8 * (i >> 2) + 4 * n + (i & 3); }
struct Unit { int pm, pn; };
struct Gemm { const bf16_t* A; const bf16_t* Bt; int M, N, K, lda, ldb; unsigned akstep = 0, atstep = 0, bkstep = 0, btstep = 0; };
struct StaticOrder {
    int nM, nN, nwg, G, c;
    __host__ __device__ void init(int M, int N, int G_, int c_) { nM = M / BM; nN = N / BM; nwg = nM * nN; G = G_; c = c_; }
    __host__ __device__ bool next(int i, Unit& u) const {
        const long L = (long)i * G + c; if (L >= nwg) return false;
        int wgid = (int)L; { const int q = nwg / NXCD, r = nwg % NXCD, xcd = wgid % NXCD, off = wgid / NXCD; wgid = (xcd < r ? xcd * (q + 1) : r * (q + 1) + (xcd - r) * q) + off; }
        const int nig = WGM * nN, gid = wgid / nig, fm = gid * WGM, gsz = (nM - fm) < WGM ? (nM - fm) : WGM;
        u.pm = fm + ((wgid % nig) % gsz); u.pn = (wgid % nig) / gsz; return true;
    }
    __device__ __forceinline__ void a_ready(const Unit&) const {}
    __device__ __forceinline__ void done(const Unit&) const {}
};
struct ReverseOrder {
    StaticOrder S; int nr; bool rev;
    __host__ __device__ void init(int M, int N, int G_, int c_) { S.init(M, N, G_, c_); nr = S.nwg / G_; rev = (nr * G_ == S.nwg); }
    __host__ __device__ bool next(int i, Unit& u) const { if (!rev) return S.next(i, u); if (i >= nr) return false; return S.next(nr - 1 - i, u); }
    __device__ __forceinline__ void a_ready(const Unit&) const {}
    __device__ __forceinline__ void done(const Unit&) const {}
};
template <class Epi, class Sched, bool ALIGN_EPI = false, bool SP2 = false>
__device__ __forceinline__ void gemm_phase(PG8_LAS unsigned char* lds, const Gemm g, const Sched& S, const Epi& E) {
    const int tid = threadIdx.x, wid = __builtin_amdgcn_readfirstlane(tid >> 6), lane = tid & 63, wr = wid >> 2, wc = wid & 3, fr = lane & 15, fq = lane >> 4;
    int nt = g.K / BK; asm volatile("" : "+s"(nt));
    unsigned voffA[2], voffB[2];
#pragma unroll
    for (int i = 0; i < 2; ++i) { int R, C; stage_rc(tid * 16 + i * 8192, R, C); const int Rb = Epi::PERM ? ((R & ~31) + perm32(R & 31)) : R;
        voffA[i] = (unsigned)(R * g.lda + C) * 2u; voffB[i] = (unsigned)(Rb * g.ldb + C) * 2u; }
    const size_t kstep = (size_t)(BK * 2);
    const size_t kstepA = g.akstep ? (size_t)g.akstep : kstep, kstepB = g.bkstep ? (size_t)g.bkstep : kstep;
    const size_t hstepA = (size_t)HALF * g.lda * 2, hstepB = (size_t)HALF * g.ldb * 2;
    const size_t tstepA = g.atstep ? (size_t)g.atstep : 2 * hstepA, tstepB = g.btstep ? (size_t)g.btstep : 2 * hstepB;
    const unsigned ldsw = (unsigned)wid * 1024u;
    const int aoff = lds_byte(wr * 64 + fr, fq * 8), boff = lds_byte(wc * 32 + fr, fq * 8);
#define PG8_SA(b, h) (((b) * 2 + (h)) * HTB)
#define PG8_SB(b, h) ((4 + (b) * 2 + (h)) * HTB)
#define PG8_STAGE(bufoff, gbase, voff) do { _Pragma("unroll") for (int _i = 0; _i < 2; ++_i) \
        __builtin_amdgcn_global_load_lds((const unsigned*)((const char*)(gbase) + (voff)[_i]), (PG8_LAS unsigned*)(lds + (bufoff) + ldsw + _i * 8192), 16, 0, 0); } while (0)
#define PG8_LDA(dst, b, h) do { _Pragma("unroll") for (int m = 0; m < 4; ++m) _Pragma("unroll") for (int k = 0; k < 2; ++k) dst[m][k] = *(const PG8_LAS bf16x8*)(lds + PG8_SA(b, h) + aoff + m * 2048 + k * 1024); } while (0)
#define PG8_LDB(dst, b, h) do { _Pragma("unroll") for (int n = 0; n < 2; ++n) _Pragma("unroll") for (int k = 0; k < 2; ++k) dst[n][k] = *(const PG8_LAS bf16x8*)(lds + PG8_SB(b, h) + boff + n * 2048 + k * 1024); } while (0)
#define PG8_MMA(ai, bj, At, Bt) do { __builtin_amdgcn_s_setprio(1); _Pragma("unroll") for (int m = 0; m < 4; ++m) _Pragma("unroll") for (int n = 0; n < 2; ++n) _Pragma("unroll") for (int k = 0; k < 2; ++k) \
        acc[ai][bj][m][n] = __builtin_amdgcn_mfma_f32_16x16x32_bf16(Bt[n][k], At[m][k], acc[ai][bj][m][n], 0, 0, 0); __builtin_amdgcn_s_setprio(0); } while (0)
#define PG8_WAIT_V(n) asm volatile("s_waitcnt vmcnt(" #n ")" ::: "memory")
#define PG8_WAIT_L(n) asm volatile("s_waitcnt lgkmcnt(" #n ")" ::: "memory")
#define PG8_BAR __builtin_amdgcn_s_barrier()
#define PG8_SCHED __builtin_amdgcn_sched_barrier(0)
    Unit cur, nxt; int ui = 0;
    if (!S.next(0, cur)) return;
    f32x4 acc[2][2][4][2];
#pragma unroll
    for (int a = 0; a < 2; ++a)
#pragma unroll
        for (int b = 0; b < 2; ++b)
#pragma unroll
            for (int m = 0; m < 4; ++m)
#pragma unroll
                for (int n = 0; n < 2; ++n) acc[a][b][m][n] = (f32x4){0.f, 0.f, 0.f, 0.f};
    bf16x8 At[4][2], B0[2][2], B1[2][2];
    const char* cA = (const char*)g.A + (size_t)cur.pm * tstepA; const char* cB = (const char*)g.Bt + (size_t)cur.pn * tstepB;
    S.a_ready(cur);
    if constexpr (SP2) {
        PG8_STAGE(PG8_SB(0, 0), cB, voffB); PG8_STAGE(PG8_SB(0, 1), cB + hstepB, voffB); PG8_STAGE(PG8_SA(0, 0), cA, voffA); PG8_STAGE(PG8_SA(0, 1), cA + hstepA, voffA);
        if (wr == 1) PG8_BAR;
        PG8_WAIT_V(2); PG8_BAR;
        PG8_STAGE(PG8_SB(1, 0), cB + kstepB, voffB); PG8_STAGE(PG8_SA(1, 0), cA + kstepA, voffA); PG8_STAGE(PG8_SB(1, 1), cB + hstepB + kstepB, voffB);
        PG8_WAIT_V(6); PG8_BAR;
    } else {
        PG8_STAGE(PG8_SB(0, 0), cB, voffB); PG8_STAGE(PG8_SA(0, 0), cA, voffA); PG8_STAGE(PG8_SB(0, 1), cB + hstepB, voffB); PG8_STAGE(PG8_SA(0, 1), cA + hstepA, voffA);
        if (wr == 1) PG8_BAR;
        PG8_WAIT_V(4); PG8_BAR;
        PG8_STAGE(PG8_SB(1, 0), cB + kstepB, voffB); PG8_STAGE(PG8_SA(1, 0), cA + kstepA, voffA); PG8_STAGE(PG8_SB(1, 1), cB + hstepB + kstepB, voffB);
        PG8_WAIT_V(6); PG8_BAR;
    }
    for (;;) {
        const bool has_next = S.next(ui + 1, nxt);
        const char* nA = has_next ? (const char*)g.A + (size_t)nxt.pm * tstepA : cA; const char* nB = has_next ? (const char*)g.Bt + (size_t)nxt.pn * tstepB : cB;
        for (int t = 0; t < nt; t += 2) {
            const bool last = (t == nt - 2);
            const char* a1 = cA + (size_t)(t + 1) * kstepA;
            const char* a2 = last ? nA : cA + (size_t)(t + 2) * kstepA; const char* b2 = last ? nB : cB + (size_t)(t + 2) * kstepB;
            const char* a3 = a2 + kstepA; const char* b3 = b2 + kstepB;
            if (last && has_next) S.a_ready(nxt);
            if constexpr (SP2) {
            PG8_LDB(B0, 0, 0); PG8_LDB(B1, 0, 1); PG8_SCHED; PG8_LDA(At, 0, 0); PG8_STAGE(PG8_SA(1, 1), a1 + hstepA, voffA);
            PG8_WAIT_V(8); PG8_WAIT_L(0); PG8_BAR; PG8_MMA(0, 0, At, B0); PG8_MMA(0, 1, At, B1); PG8_BAR; PG8_SCHED;
            PG8_LDA(At, 0, 1); PG8_STAGE(PG8_SB(0, 0), b2, voffB); PG8_STAGE(PG8_SB(0, 1), b2 + hstepB, voffB); PG8_STAGE(PG8_SA(0, 0), a2, voffA);
            PG8_WAIT_V(8); PG8_WAIT_L(0); PG8_BAR; PG8_MMA(1, 0, At, B0); PG8_MMA(1, 1, At, B1); PG8_BAR; PG8_SCHED;
            PG8_LDB(B0, 1, 0); PG8_LDB(B1, 1, 1); PG8_SCHED; PG8_LDA(At, 1, 0); PG8_STAGE(PG8_SA(0, 1), a2 + hstepA, voffA);
            PG8_WAIT_V(8); PG8_WAIT_L(0); PG8_BAR; PG8_MMA(0, 0, At, B0); PG8_MMA(0, 1, At, B1); PG8_BAR; PG8_SCHED;
            PG8_LDA(At, 1, 1); PG8_STAGE(PG8_SB(1, 0), b3, voffB); PG8_STAGE(PG8_SB(1, 1), b3 + hstepB, voffB); PG8_STAGE(PG8_SA(1, 0), a3, voffA);
            PG8_WAIT_V(8); PG8_WAIT_L(0); PG8_BAR; PG8_MMA(1, 0, At, B0); PG8_MMA(1, 1, At, B1); PG8_BAR; PG8_SCHED;
            } else {
            PG8_LDB(B0, 0, 0); PG8_SCHED; PG8_LDA(At, 0, 0); PG8_STAGE(PG8_SA(1, 1), a1 + hstepA, voffA);
            PG8_WAIT_L(8); PG8_BAR; PG8_WAIT_L(0); PG8_MMA(0, 0, At, B0); PG8_BAR; PG8_SCHED;
            PG8_LDB(B1, 0, 1); PG8_STAGE(PG8_SB(0, 0), b2, voffB);
            PG8_BAR; PG8_WAIT_L(0); PG8_MMA(0, 1, At, B1); PG8_BAR;
            PG8_LDA(At, 0, 1); PG8_STAGE(PG8_SA(0, 0), a2, voffA);
            PG8_BAR; PG8_WAIT_L(0); PG8_MMA(1, 0, At, B0); PG8_BAR; PG8_SCHED;
            PG8_STAGE(PG8_SB(0, 1), b2 + hstepB, voffB);
            PG8_WAIT_V(6); PG8_BAR; PG8_MMA(1, 1, At, B1); PG8_BAR;
            PG8_LDB(B0, 1, 0); PG8_SCHED; PG8_LDA(At, 1, 0); PG8_STAGE(PG8_SA(0, 1), a2 + hstepA, voffA);
            PG8_WAIT_L(8); PG8_BAR; PG8_WAIT_L(0); PG8_MMA(0, 0, At, B0); PG8_BAR; PG8_SCHED;
            PG8_LDB(B1, 1, 1); PG8_STAGE(PG8_SB(1, 0), b3, voffB);
            PG8_BAR; PG8_WAIT_L(0); PG8_MMA(0, 1, At, B1); PG8_BAR;
            PG8_LDA(At, 1, 1); PG8_STAGE(PG8_SA(1, 0), a3, voffA);
            PG8_BAR; PG8_WAIT_L(0); PG8_MMA(1, 0, At, B0); PG8_BAR; PG8_SCHED;
            PG8_STAGE(PG8_SB(1, 1), b3 + hstepB, voffB);
            PG8_WAIT_V(6); PG8_BAR; PG8_MMA(1, 1, At, B1); PG8_BAR;
            }
        }
        if constexpr (ALIGN_EPI) { if (wr == 0) PG8_BAR; }
        if constexpr (!Epi::AFTER_DRAIN) { E(acc, cur, wr, wc, fr, fq); S.done(cur); }
        if (!has_next) break;
#pragma unroll
        for (int a = 0; a < 2; ++a)
#pragma unroll
            for (int b = 0; b < 2; ++b)
#pragma unroll
                for (int m = 0; m < 4; ++m)
#pragma unroll
                    for (int n = 0; n < 2; ++n) acc[a][b][m][n] = (f32x4){0.f, 0.f, 0.f, 0.f};
        cur = nxt; cA = nA; cB = nB; ++ui;
        if constexpr (ALIGN_EPI) { if (wr == 1) PG8_BAR; }
    }
    PG8_WAIT_V(0);
    if constexpr (!ALIGN_EPI) { if (wr == 0) PG8_BAR; }
    PG8_BAR;
    if constexpr (Epi::AFTER_DRAIN) { E.fused(acc, cur, wr, wc, fr, fq, lds, wid, lane); S.done(cur); }
#undef PG8_SA
#undef PG8_SB
#undef PG8_STAGE
#undef PG8_LDA
#undef PG8_LDB
#undef PG8_MMA
#undef PG8_WAIT_V
#undef PG8_WAIT_L
#undef PG8_BAR
#undef PG8_SCHED
}
}
using pg8::Unit;
#define LAS __attribute__((address_space(3)))
#define LDS_WAIT() asm volatile("s_waitcnt lgkmcnt(0)" ::: "memory")

constexpr int NBATCH = 8, SEQ = 4096, T = NBATCH * SEQ, DM = 1024, DFF = 4096;
constexpr int NA = 2816, NG = 3072;
constexpr int LDSM = 768;
constexpr float EPS = 1e-6f, LOG2E = 1.4426950408889634f;
constexpr float QSCALE = 0.10206207261596575f * LOG2E;
constexpr float GLA_QSCALE = 0.08838834764831845f;
constexpr int NWAVES = 8, NTHR = 512;
constexpr int LDS_BYTES = 147456, LDS_MISC = 131072;

constexpr size_t MiB = 1u << 20;
constexpr size_t WS_WINA = 0, WS_WINB = 6 * MiB, WS_WUQ = 12 * MiB, WS_WUKV = 13 * MiB, WS_WOUT = 14 * MiB, WS_W1 = 16 * MiB, WS_W2 = 24 * MiB;
constexpr size_t WS_ROPEC = 33 * MiB, WS_ROPES = 35 * MiB, WS_SSQ = 37 * MiB, WS_CTL = 37 * MiB + 512 * 1024;
constexpr size_t WS_XN = 38 * MiB, WS_MERGED = 38 * MiB;
constexpr size_t WS_GQKV = 102 * MiB, WS_K = 230 * MiB, WS_V = 278 * MiB, WS_GATES = 102 * MiB, WS_U = 102 * MiB;
constexpr size_t WS_QO = 342 * MiB, WS_SMALL = 406 * MiB, WS_OB = 406 * MiB, WS_HB = 406 * MiB, WS_END = 470 * MiB;
constexpr int LDU = DFF + 64;

struct Args { const float* x; const int* pos; const float *g_mix, *w_in, *w_gate_f, *b_gate_f, *w_gate_b, *b_gate_b, *g_gla, *g_q, *w_uq, *g_kv, *w_ukv, *w_out, *g_mlp, *w_ff1, *w_ff2, *g_final;
              float* out; unsigned char* ws; int ph_lo, ph_hi; };

DI float wave_sum(float v) {
#pragma unroll
    for (int o = 1; o < 64; o <<= 1) v += __shfl_xor(v, o);
    return v;
}
DI float sigmoidf_(float x) { return __builtin_amdgcn_rcpf(1.0f + __builtin_amdgcn_exp2f(-LOG2E * x)); }
DI float logsig2_(float x) { return fminf(x, 0.f) * LOG2E - __builtin_amdgcn_logf(1.0f + __builtin_amdgcn_exp2f(-LOG2E * fabsf(x))); }

struct EpiP1a {
    static constexpr bool PERM = true, AFTER_DRAIN = false;
    bf16_t* gqkv; bf16_t* small; float* ssq_q; float* ssq_kv;
    DI void operator()(const f32x4 (&acc)[2][2][4][2], const Unit& u, int wr, int wc, int fr, int fq) const {
        const int row0 = u.pm * 256 + wr * 64 + fr;
#pragma unroll
        for (int bj = 0; bj < 2; ++bj) {
            const int gc = u.pn * 256 + bj * 128 + wc * 32;
            bf16_t* base; int ld, c; float* ssq = nullptr;
            if (gc < 2048) { base = gqkv; ld = 2048; c = gc; }
            else { base = small; ld = LDSM; c = gc - 2048; if (c >= 32 && c < 416) ssq = ssq_q; else if (c >= 416 && c < 672) ssq = ssq_kv; }
#pragma unroll
            for (int ai = 0; ai < 2; ++ai)
#pragma unroll
                for (int m = 0; m < 4; ++m) {
                    const int row = row0 + ai * 128 + m * 16;
                    const f32x4 v0 = acc[ai][bj][m][0], v1 = acc[ai][bj][m][1];
                    *(u32x4*)(base + (size_t)row * ld + c + 8 * fq) = pack8(v0, v1);
                    if (ssq) {
                        float s = (v0[0] * v0[0] + v0[1] * v0[1]) + (v0[2] * v0[2] + v0[3] * v0[3]) + (v1[0] * v1[0] + v1[1] * v1[1]) + (v1[2] * v1[2] + v1[3] * v1[3]);
                        s += __shfl_xor(s, 16); s += __shfl_xor(s, 32);
                        if (fq == 0) atomicAdd(ssq + row, s);
                    }
                }
        }
    }
};
struct EpiGates {
    static constexpr bool PERM = true, AFTER_DRAIN = false;
    bf16_t* gates;
    DI void operator()(const f32x4 (&acc)[2][2][4][2], const Unit& u, int wr, int wc, int fr, int fq) const {
        const int row0 = u.pm * 256 + wr * 64 + fr;
#pragma unroll
        for (int bj = 0; bj < 2; ++bj) {
            const int gc = u.pn * 256 + bj * 128 + wc * 32; const bool is_silu = gc < 1024;
#pragma unroll
            for (int ai = 0; ai < 2; ++ai)
#pragma unroll
                for (int m = 0; m < 4; ++m) {
                    const int row = row0 + ai * 128 + m * 16;
                    f32x4 v0 = acc[ai][bj][m][0], v1 = acc[ai][bj][m][1];
#pragma unroll
                    for (int e = 0; e < 4; ++e) { const float s0 = sigmoidf_(v0[e]), s1 = sigmoidf_(v1[e]); v0[e] = is_silu ? v0[e] * s0 : s0; v1[e] = is_silu ? v1[e] * s1 : s1; }
                    *(u32x4*)(gates + (size_t)row * NG + gc + 8 * fq) = pack8(v0, v1);
                }
        }
    }
};
struct EpiQ {
    static constexpr bool PERM = true, AFTER_DRAIN = false;
    bf16_t* qo; const float* ssq; const float* rc; const float* rsn;
    DI void operator()(const f32x4 (&acc)[2][2][4][2], const Unit& u, int wr, int wc, int fr, int fq) const {
        const int row0 = u.pm * 256 + wr * 64 + fr;
#pragma unroll
        for (int bj = 0; bj < 2; ++bj) {
            const int gc = u.pn * 256 + bj * 128 + wc * 32; const int h = gc / 96, j0 = gc - h * 96; const bool rope = (j0 == 64);
            const int dcol = h * 128 + j0 + 8 * fq;
#pragma unroll
            for (int ai = 0; ai < 2; ++ai)
#pragma unroll
                for (int m = 0; m < 4; ++m) {
                    const int row = row0 + ai * 128 + m * 16;
                    const float rs = rsqrtf(ssq[row] * (1.0f / 384.0f) + EPS);
                    f32x4 v0 = acc[ai][bj][m][0] * rs, v1 = acc[ai][bj][m][1] * rs;
                    if (rope) {
                        const int i0 = 8 * (fq & 1);
                        const f32x4 c0 = *(const f32x4*)(rc + (size_t)row * 16 + i0), c1 = *(const f32x4*)(rc + (size_t)row * 16 + i0 + 4);
                        const f32x4 s0 = *(const f32x4*)(rsn + (size_t)row * 16 + i0), s1 = *(const f32x4*)(rsn + (size_t)row * 16 + i0 + 4);
                        const float sg = (fq < 2) ? -1.0f : 1.0f;
                        f32x4 p0, p1;
#pragma unroll
                        for (int e = 0; e < 4; ++e) { p0[e] = __shfl_xor(v0[e], 32); p1[e] = __shfl_xor(v1[e], 32); }
                        v0 = v0 * c0 + (p0 * s0) * sg; v1 = v1 * c1 + (p1 * s1) * sg;
                    }
                    v0 = v0 * QSCALE; v1 = v1 * QSCALE;
                    *(u32x4*)(qo + (size_t)row * 1024 + dcol) = pack8(v0, v1);
                    asm volatile("" ::: "memory");
                }
        }
    }
};
struct EpiKV {
    static constexpr bool PERM = true, AFTER_DRAIN = false;
    bf16_t* kb; bf16_t* vb; const float* ssq;
    DI void operator()(const f32x4 (&acc)[2][2][4][2], const Unit& u, int wr, int wc, int fr, int fq) const {
        const int row0 = u.pm * 256 + wr * 64 + fr;
#pragma unroll
        for (int bj = 0; bj < 2; ++bj) {
            const int gc = u.pn * 256 + bj * 128 + wc * 32; const int h = gc / 192, j0 = gc - h * 192;
            bf16_t* base; int ld, c;
            if (j0 < 64) { base = kb; ld = 768; c = h * 96 + j0 + 8 * fq; } else { base = vb; ld = 1024; c = h * 128 + (j0 - 64) + 8 * fq; }
#pragma unroll
            for (int ai = 0; ai < 2; ++ai)
#pragma unroll
                for (int m = 0; m < 4; ++m) {
                    const int row = row0 + ai * 128 + m * 16;
                    const float rs = rsqrtf(ssq[row] * (1.0f / 256.0f) + EPS);
                    *(u32x4*)(base + (size_t)row * ld + c) = pack8(acc[ai][bj][m][0] * rs, acc[ai][bj][m][1] * rs);
                }
        }
    }
};
template <bool WRITE_HB> struct EpiRes {
    static constexpr bool PERM = true, AFTER_DRAIN = false;
    const float* base; float* out; bf16_t* hb; float* ssq;
    DI void operator()(const f32x4 (&acc)[2][2][4][2], const Unit& u, int wr, int wc, int fr, int fq) const {
        const int row0 = u.pm * 256 + wr * 64 + fr; const int colb = u.pn * 256 + wc * 32 + 8 * fq;
#pragma unroll
        for (int ai = 0; ai < 2; ++ai) {
            f32x4 pre[4][2][2];
#pragma unroll
            for (int m = 0; m < 4; ++m)
#pragma unroll
                for (int bj = 0; bj < 2; ++bj) { const size_t off = (size_t)(row0 + ai * 128 + m * 16) * DM + colb + bj * 128;
                    pre[m][bj][0] = *(const f32x4*)(base + off); pre[m][bj][1] = *(const f32x4*)(base + off + 4); }
            asm volatile("" ::: "memory");
#pragma unroll
            for (int m = 0; m < 4; ++m) {
                const int row = row0 + ai * 128 + m * 16; float s = 0.f;
#pragma unroll
                for (int bj = 0; bj < 2; ++bj) {
                    const size_t off = (size_t)row * DM + colb + bj * 128;
                    const f32x4 v0 = pre[m][bj][0] + acc[ai][bj][m][0], v1 = pre[m][bj][1] + acc[ai][bj][m][1];
                    *(f32x4*)(out + off) = v0; *(f32x4*)(out + off + 4) = v1;
                    if (WRITE_HB) *(u32x4*)(hb + off) = pack8(v0, v1);
                    s += (v0[0] * v0[0] + v0[1] * v0[1]) + (v0[2] * v0[2] + v0[3] * v0[3]) + (v1[0] * v1[0] + v1[1] * v1[1]) + (v1[2] * v1[2] + v1[3] * v1[3]);
                }
                s += __shfl_xor(s, 16); s += __shfl_xor(s, 32);
                if (fq == 0) atomicAdd(ssq + row, s);
            }
            asm volatile("" ::: "memory");
        }
    }
};
template <bool BASE_BF16> struct EpiResB {
    static constexpr bool PERM = true, AFTER_DRAIN = false;
    const void* base; bf16_t* hb; float* ssq;
    DI void operator()(const f32x4 (&acc)[2][2][4][2], const Unit& u, int wr, int wc, int fr, int fq) const {
        const int row0 = u.pm * 256 + wr * 64 + fr; const int colb = u.pn * 256 + wc * 32 + 8 * fq;
#pragma unroll
        for (int ai = 0; ai < 2; ++ai) {
            f32x4 pre[4][2][2];
#pragma unroll
            for (int m = 0; m < 4; ++m)
#pragma unroll
                for (int bj = 0; bj < 2; ++bj) { const size_t off = (size_t)(row0 + ai * 128 + m * 16) * DM + colb + bj * 128;
                    if (BASE_BF16) { float f[8]; unpack8(*(const u32x4*)((const bf16_t*)base + off), f); pre[m][bj][0] = (f32x4){f[0], f[1], f[2], f[3]}; pre[m][bj][1] = (f32x4){f[4], f[5], f[6], f[7]}; }
                    else { pre[m][bj][0] = *(const f32x4*)((const float*)base + off); pre[m][bj][1] = *(const f32x4*)((const float*)base + off + 4); } }
            asm volatile("" ::: "memory");
#pragma unroll
            for (int m = 0; m < 4; ++m) {
                const int row = row0 + ai * 128 + m * 16; float s = 0.f;
#pragma unroll
                for (int bj = 0; bj < 2; ++bj) {
                    const size_t off = (size_t)row * DM + colb + bj * 128;
                    const f32x4 v0 = pre[m][bj][0] + acc[ai][bj][m][0], v1 = pre[m][bj][1] + acc[ai][bj][m][1];
                    *(u32x4*)(hb + off) = pack8(v0, v1);
                    s += (v0[0] * v0[0] + v0[1] * v0[1]) + (v0[2] * v0[2] + v0[3] * v0[3]) + (v1[0] * v1[0] + v1[1] * v1[1]) + (v1[2] * v1[2] + v1[3] * v1[3]);
                }
                if (ssq) { s += __shfl_xor(s, 16); s += __shfl_xor(s, 32);
                    if (fq == 0) atomicAdd(ssq + row, s); }
            }
            asm volatile("" ::: "memory");
        }
    }
};
struct EpiFF1 {
    static constexpr bool PERM = true, AFTER_DRAIN = false;
    bf16_t* ub; const float* ssq;
    DI void operator()(const f32x4 (&acc)[2][2][4][2], const Unit& u, int wr, int wc, int fr, int fq) const {
        const int row0 = u.pm * 256 + wr * 64 + fr;
#pragma unroll
        for (int ai = 0; ai < 2; ++ai)
#pragma unroll
            for (int m = 0; m < 4; ++m) {
                const int row = row0 + ai * 128 + m * 16;
                const float rs = rsqrtf(ssq[row] * (1.0f / 1024.0f) + EPS);
#pragma unroll
                for (int bj = 0; bj < 2; ++bj) {
                    f32x4 v0 = acc[ai][bj][m][0] * rs, v1 = acc[ai][bj][m][1] * rs;
#pragma unroll
                    for (int e = 0; e < 4; ++e) { const float a = fmaxf(v0[e], 0.f), b = fmaxf(v1[e], 0.f); v0[e] = a * a; v1[e] = b * b; }
                    { const int col = u.pn * 256 + bj * 128 + wc * 32 + 8 * fq;
                      *(u32x4*)(ub + (((size_t)(row >> 8) * (DFF / 64) + (col >> 6)) * 256 + (row & 255)) * 64 + (col & 63)) = pack8(v0, v1); }
                }
            }
    }
};

namespace att {
constexpr int QBLK = 32, KVBLK = 64, LDQ = 1024, LDKK = 768, LDKV = 1024;
#ifndef ATT_SDEPTH
#define ATT_SDEPTH 1
#endif
constexpr int SDEPTH = ATT_SDEPTH;
constexpr float THRL = 11.5f;
constexpr size_t SHM_V = KVBLK * 128 * 2, SHM_K = KVBLK * 256, SHM_ATTN = 2 * SHM_V + 2 * SHM_K + NWAVES * 64 * 4;
#define KSWZ(row, colB) ((row) * 256 + ((colB) ^ (((row) & 15) << 4)))
#define SBAR() __builtin_amdgcn_sched_barrier(0)
DI int crow(int r, int hi) { return (r & 3) + 8 * (r >> 2) + 4 * hi; }
DI void partialSM(f32x16& p0, f32x16& p1, float& m_reg, float& mn, float& alpha) {
  float pmax = p0[0];
#pragma unroll
  for (int r = 1; r < 16; ++r) pmax = fmaxf(pmax, p0[r]);
#pragma unroll
  for (int r = 0; r < 16; ++r) pmax = fmaxf(pmax, p1[r]);
  { auto rr = __builtin_amdgcn_permlane32_swap(__float_as_uint(pmax), __float_as_uint(pmax), false, false);
    pmax = fmaxf(__uint_as_float(rr[0]), __uint_as_float(rr[1])); }
  if (__builtin_expect(__all(pmax - m_reg <= THRL), 1)) { mn = m_reg; alpha = 1.f; }
  else { mn = fmaxf(m_reg, pmax); alpha = __builtin_amdgcn_exp2f(m_reg - mn); m_reg = mn; }
#pragma unroll
  for (int r = 0; r < 16; ++r) p0[r] = p0[r] - mn;
#pragma unroll
  for (int r = 0; r < 16; ++r) p1[r] = p1[r] - mn;
#pragma unroll
  for (int r = 0; r < 16; ++r) p0[r] = __builtin_amdgcn_exp2f(p0[r]);
}
DI void finishSM(f32x16& p0, f32x16& p1, float alpha, float& l_reg, bf16x8& pa0, bf16x8& pa1, bf16x8& pa2, bf16x8& pa3) {
#pragma unroll
  for (int r = 0; r < 16; ++r) p1[r] = __builtin_amdgcn_exp2f(p1[r]);
  float ps = 0;
#pragma unroll
  for (int r = 0; r < 16; ++r) ps += p0[r];
#pragma unroll
  for (int r = 0; r < 16; ++r) ps += p1[r];
  { auto rr = __builtin_amdgcn_permlane32_swap(__float_as_uint(ps), __float_as_uint(ps), false, false);
    ps = __uint_as_float(rr[0]) + __uint_as_float(rr[1]); }
  l_reg = l_reg * alpha + ps;
#define PK4(P, BASE, OUT) do { unsigned a0 = cvt_pk_bf16(P[BASE + 0], P[BASE + 1]), a1 = cvt_pk_bf16(P[BASE + 2], P[BASE + 3]);   \
    unsigned b0 = cvt_pk_bf16(P[BASE + 4], P[BASE + 5]), b1 = cvt_pk_bf16(P[BASE + 6], P[BASE + 7]);                              \
    auto r0 = __builtin_amdgcn_permlane32_swap(a0, b0, false, false); auto r1 = __builtin_amdgcn_permlane32_swap(a1, b1, false, false); \
    u32x4 w = {r0[0], r1[0], r0[1], r1[1]}; OUT = *reinterpret_cast<bf16x8*>(&w); } while (0)
  PK4(p0, 0, pa0); PK4(p0, 8, pa1); PK4(p1, 0, pa2); PK4(p1, 8, pa3);
#undef PK4
}
DI void qkt(f32x16& p0, f32x16& p1, const bf16_t* Ks, const bf16x8* qr, int r32, int hi) {
  p0 = f32x16{}; p1 = f32x16{};
#pragma unroll
  for (int d0 = 0; d0 < 6; ++d0) { const int cb = (d0 * 16 + hi * 8) * 2;
    bf16x8 b0 = *reinterpret_cast<const bf16x8*>((const char*)Ks + KSWZ(r32, cb));
    bf16x8 b1 = *reinterpret_cast<const bf16x8*>((const char*)Ks + KSWZ(32 + r32, cb));
    p0 = __builtin_amdgcn_mfma_f32_32x32x16_bf16(b0, qr[d0], p0, 0, 0, 0);
    p1 = __builtin_amdgcn_mfma_f32_32x32x16_bf16(b1, qr[d0], p1, 0, 0, 0); }
}
DI int v_st(int k, int c) { const int kk = (k & ~0xC) | ((k & 4) << 1) | ((k & 8) >> 1); return ((kk >> 3) * 4 + (c >> 5)) * 512 + ((kk & 7) * 32 + (c & 31)) * 2; }
DI int v_rd_base(int lane) { return ((lane & 3) << 3) | (((lane >> 2) & 3) << 6) | (((lane >> 4) & 1) << 5) | (((lane >> 5) & 1) << 8); }
constexpr int v_rd_off(int d0, int ks, int half) { return d0 * 512 + ks * 4096 + half * 2048; }
template <int OFF> DI s16x4 tr_read(int vb) {
  s16x4 r; asm volatile("ds_read_b64_tr_b16 %0, %1 offset:%2" : "=&v"(r) : "v"(vb), "i"(OFF) : "memory"); return r;
}
template <int D0> DI void pv_one(f32x16& od, int vb, bf16x8 pa0, bf16x8 pa1, bf16x8 pa2, bf16x8 pa3) {
  const s16x4 l0 = tr_read<v_rd_off(D0, 0, 0)>(vb), h0 = tr_read<v_rd_off(D0, 0, 1)>(vb), l1 = tr_read<v_rd_off(D0, 1, 0)>(vb), h1 = tr_read<v_rd_off(D0, 1, 1)>(vb);
  const s16x4 l2 = tr_read<v_rd_off(D0, 2, 0)>(vb), h2 = tr_read<v_rd_off(D0, 2, 1)>(vb), l3 = tr_read<v_rd_off(D0, 3, 0)>(vb), h3 = tr_read<v_rd_off(D0, 3, 1)>(vb);
  asm volatile("s_waitcnt lgkmcnt(0)" ::: "memory"); SBAR();
#define PK(L, H) (bf16x8){L[0], L[1], L[2], L[3], H[0], H[1], H[2], H[3]}
  od = __builtin_amdgcn_mfma_f32_32x32x16_bf16(pa0, PK(l0, h0), od, 0, 0, 0);
  od = __builtin_amdgcn_mfma_f32_32x32x16_bf16(pa1, PK(l1, h1), od, 0, 0, 0);
  od = __builtin_amdgcn_mfma_f32_32x32x16_bf16(pa2, PK(l2, h2), od, 0, 0, 0);
  od = __builtin_amdgcn_mfma_f32_32x32x16_bf16(pa3, PK(l3, h3), od, 0, 0, 0);
#undef PK
}
DI void pv_d0(f32x16* o, int vb, bf16x8 pa0, bf16x8 pa1, bf16x8 pa2, bf16x8 pa3) {
  pv_one<0>(o[0], vb, pa0, pa1, pa2, pa3); pv_one<1>(o[1], vb, pa0, pa1, pa2, pa3); pv_one<2>(o[2], vb, pa0, pa1, pa2, pa3); pv_one<3>(o[3], vb, pa0, pa1, pa2, pa3);
}
DI void attn_dense_body(const bf16_t* Qb, const bf16_t* __restrict__ Kh, const bf16_t* __restrict__ Vh, bf16_t* Ob, int seq, char* lds) {
  const int tid = threadIdx.x, wid = tid >> 6, lane = tid & 63, r32 = lane & 31, hi = lane >> 5;
  bf16_t* V_lds = (bf16_t*)lds; bf16_t* K_lds = (bf16_t*)(lds + 2 * SHM_V);
  float* ws = (float*)(lds + 2 * SHM_V + 2 * SHM_K) + wid * 64; float* li_l = ws; float* al_l = ws + 32;
  float m_reg = -1e30f, l_reg = 0; f32x16 o[4] = {}; bf16x8 qr[6];
  const bf16_t* Qw = Qb + (long)(wid * QBLK + r32) * LDQ + hi * 8;
#pragma unroll
  for (int d0 = 0; d0 < 6; ++d0) qr[d0] = *reinterpret_cast<const bf16x8*>(Qw + d0 * 16);
  const int sr = tid >> 4, sc = (tid & 15) * 8, vst0 = v_st(sr, sc), vst1 = v_st(32 + sr, sc);
  const int kr0 = tid / 12, kc0 = (tid - kr0 * 12) * 8, kr1 = (tid + 512) / 12, kc1 = ((tid + 512) - kr1 * 12) * 8;
  const bool k2 = wid < 4;
  const int kst0 = KSWZ(kr0, kc0 * 2), kst1 = KSWZ(kr1, kc1 * 2);
  const int vb0 = (int)(uintptr_t)V_lds + v_rd_base(lane);
  struct { bf16x8 vs0, vs1, ks0, ks1; } sr_[SDEPTH];
#define SLOAD(i, k0) do { sr_[i].vs0 = *(const bf16x8*)(&Vh[(long)((k0) + sr) * LDKV + sc]); sr_[i].vs1 = *(const bf16x8*)(&Vh[(long)((k0) + 32 + sr) * LDKV + sc]); \
    sr_[i].ks0 = *(const bf16x8*)(&Kh[(long)((k0) + kr0) * LDKK + kc0]); if (k2) sr_[i].ks1 = *(const bf16x8*)(&Kh[(long)((k0) + kr1) * LDKK + kc1]); } while (0)
#define SWRITE(b, i) do { *(bf16x8*)((char*)V_lds + (b) * SHM_V + vst0) = sr_[i].vs0; *(bf16x8*)((char*)V_lds + (b) * SHM_V + vst1) = sr_[i].vs1; \
    *(bf16x8*)((char*)K_lds + (b) * SHM_K + kst0) = sr_[i].ks0; if (k2) *(bf16x8*)((char*)K_lds + (b) * SHM_K + kst1) = sr_[i].ks1; } while (0)
#define SWAIT() do { if (SDEPTH == 2) asm volatile("s_waitcnt vmcnt(4)" ::: "memory"); else asm volatile("s_waitcnt vmcnt(0)" ::: "memory"); } while (0)
#define RESC(a) do { if (__any((a) < 1.f)) { if (hi == 0) al_l[r32] = (a); asm volatile("s_waitcnt lgkmcnt(0)" ::: "memory"); \
    _Pragma("unroll") for (int d = 0; d < 4; ++d) _Pragma("unroll") for (int r = 0; r < 16; ++r) o[d][r] *= al_l[crow(r, hi)]; } } while (0)
  f32x16 pA0, pA1, pB0, pB1; float mnA, mnB, alA, alB; bf16x8 pa0, pa1, pa2, pa3; const int NT = seq / KVBLK;
  constexpr int SE = 0, SO = SDEPTH - 1;
  SLOAD(SE, 0); asm volatile("s_waitcnt vmcnt(0)" ::: "memory"); SWRITE(0, SE); __syncthreads();
  qkt(pA0, pA1, K_lds, qr, r32, hi); partialSM(pA0, pA1, m_reg, mnA, alA);
  SLOAD(SO, KVBLK); if (SDEPTH == 2) { if (2 < NT) SLOAD(SE, 2 * KVBLK); }
  SWAIT(); SWRITE(1, SO); __syncthreads();
  for (int j = 1; j + 1 < NT; j += 2) {
    SBAR(); qkt(pB0, pB1, (bf16_t*)((char*)K_lds + SHM_K), qr, r32, hi);
    finishSM(pA0, pA1, alA, l_reg, pa0, pa1, pa2, pa3); SBAR();
    SLOAD(SO, (j + SDEPTH) * KVBLK); SBAR();
    pv_d0(o, vb0, pa0, pa1, pa2, pa3); partialSM(pB0, pB1, m_reg, mnB, alB);
    __syncthreads(); SWAIT(); SWRITE(0, SE);
    RESC(alB); __syncthreads();
    SBAR(); qkt(pA0, pA1, K_lds, qr, r32, hi);
    finishSM(pB0, pB1, alB, l_reg, pa0, pa1, pa2, pa3); SBAR();
    if (SDEPTH == 1 || j + 3 < NT) SLOAD(SE, (j + 1 + SDEPTH) * KVBLK); SBAR();
    pv_d0(o, vb0 + (int)SHM_V, pa0, pa1, pa2, pa3); partialSM(pA0, pA1, m_reg, mnA, alA);
    __syncthreads(); SWAIT(); SWRITE(1, SO);
    RESC(alA); __syncthreads();
  }
  SBAR(); qkt(pB0, pB1, (bf16_t*)((char*)K_lds + SHM_K), qr, r32, hi);
  finishSM(pA0, pA1, alA, l_reg, pa0, pa1, pa2, pa3); SBAR();
  pv_d0(o, vb0, pa0, pa1, pa2, pa3); partialSM(pB0, pB1, m_reg, mnB, alB);
  __syncthreads(); RESC(alB);
  finishSM(pB0, pB1, alB, l_reg, pa0, pa1, pa2, pa3); SBAR();
  pv_d0(o, vb0 + (int)SHM_V, pa0, pa1, pa2, pa3);
  if (hi == 0) li_l[r32] = l_reg; asm volatile("s_waitcnt lgkmcnt(0)" ::: "memory");
  float rli[16];
#pragma unroll
  for (int r = 0; r < 16; ++r) rli[r] = __builtin_amdgcn_rcpf(li_l[crow(r, hi)]);
  bf16_t* Ow = Ob + (long)(wid * QBLK) * LDQ;
#pragma unroll
  for (int r = 0; r < 16; ++r) { const int orow = crow(r, hi);
#pragma unroll
    for (int d0 = 0; d0 < 4; ++d0) Ow[(long)orow * LDQ + d0 * 32 + r32] = (bf16_t)(cvt_pk_bf16(o[d0][r] * rli[r], 0.f) & 0xffffu); }
  __syncthreads();
#undef SLOAD
#undef SWRITE
#undef SWAIT
#undef RESC
}
}

namespace gla {
constexpr int QD_OFF = 0, KD_OFF = 17408, KE_OFF = 34816, VV_OFF = 51200, PP_OFF = 83968, DD_OFF = 93184, QROW = 272, PROW = 144;
#define GLA_BAR() do { asm volatile("s_waitcnt lgkmcnt(0)" ::: "memory"); __builtin_amdgcn_s_barrier(); asm volatile("" ::: "memory"); } while (0)
#define MFMA32(a, b, c) __builtin_amdgcn_mfma_f32_32x32x16_bf16((a), (b), (c), 0, 0, 0)
DI bf16x8 pack_step(const f32x16& x, int s) {
    u32x4 p; p.x = cvt_pk_bf16(x[8 * s], x[8 * s + 1]); p.y = cvt_pk_bf16(x[8 * s + 2], x[8 * s + 3]); p.z = cvt_pk_bf16(x[8 * s + 4], x[8 * s + 5]); p.w = cvt_pk_bf16(x[8 * s + 6], x[8 * s + 7]);
    return __builtin_bit_cast(bf16x8, p);
}
template <int DIR> DI void unit(int b, int h, const bf16_t* __restrict__ gqkv, const _Float16* __restrict__ bc, bf16_t* __restrict__ oo, char* lds) {
    using att::v_st; using att::v_rd_base; using att::v_rd_off; using att::tr_read; using att::crow;
    const int tid = threadIdx.x, lane = tid & 63, wid = tid >> 6, r32 = lane & 31, hi = lane >> 5, fr = lane & 15, fq = lane >> 4;
    const int t = tid >> 3, g = tid & 7, sr = tid >> 4, sc = (tid & 15) * 8;
    char* QD = lds + QD_OFF; char* KD = lds + KD_OFF; char* KE = lds + KE_OFF; char* VV = lds + VV_OFF; char* PP = lds + PP_OFF; float* DD = (float*)(lds + DD_OFF);
    const int vst0 = v_st(sr, sc), vst1 = v_st(32 + sr, sc), kst0 = v_st(t, 16 * g), kst1 = v_st(t, 16 * g + 8);
    const int vb = (int)(uintptr_t)VV + (wid >> 2) * 16384 + (wid & 3) * 512 + v_rd_base(lane), keb = (int)(uintptr_t)KE + v_rd_base(lane);
    f32x16 st[4] = {};
    u32x4 q0, q1, k0, k1; f16x8 b0, b1, l0, l1; bf16x8 vs0, vs1, vs2, vs3;
#define GLOAD(ci_) do { const int chunk_ = DIR ? 63 - (ci_) : (ci_); const long row0_ = (long)b * SEQ + chunk_ * 64; \
        const bf16_t* qp_ = gqkv + (row0_ + t) * 2048 + h * 128 + g * 16; q0 = *(const u32x4*)qp_; q1 = *(const u32x4*)(qp_ + 8); k0 = *(const u32x4*)(qp_ + 512); k1 = *(const u32x4*)(qp_ + 520); \
        const _Float16* bp_ = bc + (row0_ + t) * 512 + h * 128 + g * 16; b0 = *(const f16x8*)bp_; b1 = *(const f16x8*)(bp_ + 8); \
        const _Float16* lp_ = bc + (row0_ + (DIR ? 0 : 63)) * 512 + h * 128 + g * 16; l0 = *(const f16x8*)lp_; l1 = *(const f16x8*)(lp_ + 8); \
        const bf16_t* vp_ = gqkv + (row0_ + sr) * 2048 + 1024 + h * 256 + sc; vs0 = *(const bf16x8*)vp_; vs1 = *(const bf16x8*)(vp_ + 128); vs2 = *(const bf16x8*)(vp_ + 32 * 2048); vs3 = *(const bf16x8*)(vp_ + 32 * 2048 + 128); } while (0)
    GLOAD(0);
    for (int ci = 0; ci < 64; ++ci) {
        const int chunk = DIR ? 63 - ci : ci; const long row0 = (long)b * SEQ + chunk * 64;
        { float qf[16], kf[16]; unpack8(q0, qf); unpack8(q1, qf + 8); unpack8(k0, kf); unpack8(k1, kf + 8);
          float qd[16], kd[16], ke[16], dl[16];
#pragma unroll
          for (int j = 0; j < 16; ++j) { const float bb = (float)(j < 8 ? b0[j & 7] : b1[j & 7]), ll = (float)(j < 8 ? l0[j & 7] : l1[j & 7]);
              qd[j] = qf[j] * GLA_QSCALE * __builtin_amdgcn_exp2f(bb); kd[j] = kf[j] * __builtin_amdgcn_exp2f(-bb); ke[j] = kf[j] * __builtin_amdgcn_exp2f(ll - bb); dl[j] = __builtin_amdgcn_exp2f(ll); }
          u32x4 w;
          w.x = cvt_pk_bf16(qd[0], qd[1]); w.y = cvt_pk_bf16(qd[2], qd[3]); w.z = cvt_pk_bf16(qd[4], qd[5]); w.w = cvt_pk_bf16(qd[6], qd[7]); *(u32x4*)(QD + t * QROW + g * 32) = w;
          w.x = cvt_pk_bf16(qd[8], qd[9]); w.y = cvt_pk_bf16(qd[10], qd[11]); w.z = cvt_pk_bf16(qd[12], qd[13]); w.w = cvt_pk_bf16(qd[14], qd[15]); *(u32x4*)(QD + t * QROW + g * 32 + 16) = w;
          w.x = cvt_pk_bf16(kd[0], kd[1]); w.y = cvt_pk_bf16(kd[2], kd[3]); w.z = cvt_pk_bf16(kd[4], kd[5]); w.w = cvt_pk_bf16(kd[6], kd[7]); *(u32x4*)(KD + t * QROW + g * 32) = w;
          w.x = cvt_pk_bf16(kd[8], kd[9]); w.y = cvt_pk_bf16(kd[10], kd[11]); w.z = cvt_pk_bf16(kd[12], kd[13]); w.w = cvt_pk_bf16(kd[14], kd[15]); *(u32x4*)(KD + t * QROW + g * 32 + 16) = w;
          w.x = cvt_pk_bf16(ke[0], ke[1]); w.y = cvt_pk_bf16(ke[2], ke[3]); w.z = cvt_pk_bf16(ke[4], ke[5]); w.w = cvt_pk_bf16(ke[6], ke[7]); *(u32x4*)(KE + kst0) = w;
          w.x = cvt_pk_bf16(ke[8], ke[9]); w.y = cvt_pk_bf16(ke[10], ke[11]); w.z = cvt_pk_bf16(ke[12], ke[13]); w.w = cvt_pk_bf16(ke[14], ke[15]); *(u32x4*)(KE + kst1) = w;
          if (t == (DIR ? 0 : 63)) {
#pragma unroll
              for (int j = 0; j < 16; ++j) DD[16 * g + j] = dl[j]; }
          *(bf16x8*)(VV + vst0) = vs0; *(bf16x8*)(VV + 16384 + vst0) = vs1; *(bf16x8*)(VV + vst1) = vs2; *(bf16x8*)(VV + 16384 + vst1) = vs3; }
        if (ci + 1 < 64) GLOAD(ci + 1);
        GLA_BAR();
        { const int ti = wid >> 1, jb = (wid & 1) * 2; f32x4 s0 = {0.f, 0.f, 0.f, 0.f}, s1 = s0;
#pragma unroll
          for (int ks = 0; ks < 4; ++ks) {
              const bf16x8 af = *(const bf16x8*)(QD + (16 * ti + fr) * QROW + (ks * 32 + fq * 8) * 2);
              const bf16x8 bf0 = *(const bf16x8*)(KD + (16 * jb + fr) * QROW + (ks * 32 + fq * 8) * 2), bf1 = *(const bf16x8*)(KD + (16 * jb + 16 + fr) * QROW + (ks * 32 + fq * 8) * 2);
              s0 = __builtin_amdgcn_mfma_f32_16x16x32_bf16(af, bf0, s0, 0, 0, 0); s1 = __builtin_amdgcn_mfma_f32_16x16x32_bf16(af, bf1, s1, 0, 0, 0); }
#pragma unroll
          for (int r = 0; r < 4; ++r) { const int tt = 16 * ti + 4 * fq + r, c0 = 16 * jb + fr, c1 = c0 + 16;
              const bool keep0 = DIR ? (c0 > tt) : (c0 <= tt), keep1 = DIR ? (c1 > tt) : (c1 <= tt);
              *(bf16_t*)(PP + tt * PROW + c0 * 2) = (bf16_t)(cvt_pk_bf16(keep0 ? s0[r] : 0.f, 0.f) & 0xffffu);
              *(bf16_t*)(PP + tt * PROW + c1 * 2) = (bf16_t)(cvt_pk_bf16(keep1 ? s1[r] : 0.f, 0.f) & 0xffffu); } }
        GLA_BAR();
        { bf16x8 vf[4];
          { const s16x4 a0 = tr_read<v_rd_off(0, 0, 0)>(vb), c0 = tr_read<v_rd_off(0, 0, 1)>(vb), a1 = tr_read<v_rd_off(0, 1, 0)>(vb), c1 = tr_read<v_rd_off(0, 1, 1)>(vb);
            const s16x4 a2 = tr_read<v_rd_off(0, 2, 0)>(vb), c2 = tr_read<v_rd_off(0, 2, 1)>(vb), a3 = tr_read<v_rd_off(0, 3, 0)>(vb), c3 = tr_read<v_rd_off(0, 3, 1)>(vb);
            asm volatile("s_waitcnt lgkmcnt(0)" ::: "memory"); __builtin_amdgcn_sched_barrier(0);
#define PKV(L, H) (bf16x8){L[0], L[1], L[2], L[3], H[0], H[1], H[2], H[3]}
            vf[0] = PKV(a0, c0); vf[1] = PKV(a1, c1); vf[2] = PKV(a2, c2); vf[3] = PKV(a3, c3); }
          f32x16 o0 = {}, o1 = {};
#pragma unroll
          for (int ks = 0; ks < 4; ++ks) {
              const bf16x8 pa0 = *(const bf16x8*)(PP + r32 * PROW + (16 * ks + 8 * hi) * 2), pa1 = *(const bf16x8*)(PP + (32 + r32) * PROW + (16 * ks + 8 * hi) * 2);
              o0 = MFMA32(pa0, vf[ks], o0); o1 = MFMA32(pa1, vf[ks], o1); }
#pragma unroll
          for (int ti = 0; ti < 4; ++ti)
#pragma unroll
              for (int s = 0; s < 2; ++s) {
                  const bf16x8 sb = pack_step(st[ti], s);
                  const char* qa = QD + r32 * QROW + (32 * ti + 16 * s + 4 * hi) * 2;
                  const s16x4 x0 = *(const s16x4*)qa, x1 = *(const s16x4*)(qa + 16), y0 = *(const s16x4*)(qa + 32 * QROW), y1 = *(const s16x4*)(qa + 32 * QROW + 16);
                  o0 = MFMA32(PKV(x0, x1), sb, o0); o1 = MFMA32(PKV(y0, y1), sb, o1); }
          bf16_t* op = oo + (row0) * 1024 + h * 256 + wid * 32 + r32;
#pragma unroll
          for (int r = 0; r < 16; ++r) { const int tr = crow(r, hi);
              op[(long)tr * 1024] = (bf16_t)(cvt_pk_bf16(o0[r], 0.f) & 0xffffu); op[(long)(32 + tr) * 1024] = (bf16_t)(cvt_pk_bf16(o1[r], 0.f) & 0xffffu); }
#define KE_TILE(TI) do { \
              const s16x4 a0 = tr_read<v_rd_off(TI, 0, 0)>(keb), c0 = tr_read<v_rd_off(TI, 0, 1)>(keb), a1 = tr_read<v_rd_off(TI, 1, 0)>(keb), c1 = tr_read<v_rd_off(TI, 1, 1)>(keb); \
              const s16x4 a2 = tr_read<v_rd_off(TI, 2, 0)>(keb), c2 = tr_read<v_rd_off(TI, 2, 1)>(keb), a3 = tr_read<v_rd_off(TI, 3, 0)>(keb), c3 = tr_read<v_rd_off(TI, 3, 1)>(keb); \
              _Pragma("unroll") for (int gq = 0; gq < 4; ++gq) { const f32x4 dv = *(const f32x4*)(DD + 32 * TI + 8 * gq + 4 * hi); \
                  st[TI][4 * gq] *= dv[0]; st[TI][4 * gq + 1] *= dv[1]; st[TI][4 * gq + 2] *= dv[2]; st[TI][4 * gq + 3] *= dv[3]; } \
              asm volatile("s_waitcnt lgkmcnt(0)" ::: "memory"); __builtin_amdgcn_sched_barrier(0); \
              st[TI] = MFMA32(PKV(a0, c0), vf[0], st[TI]); st[TI] = MFMA32(PKV(a1, c1), vf[1], st[TI]); st[TI] = MFMA32(PKV(a2, c2), vf[2], st[TI]); st[TI] = MFMA32(PKV(a3, c3), vf[3], st[TI]); } while (0)
          KE_TILE(0); KE_TILE(1); KE_TILE(2); KE_TILE(3);
#undef KE_TILE
#undef PKV
        }
        GLA_BAR();
    }
#undef GLOAD
}
}

template <int DIR> DI void gla_naive_unit(int b, int h, const bf16_t* gqkv, const _Float16* bc, bf16_t* oo, unsigned char* ldsg) {
    const int tid = threadIdx.x;
    float* qs = (float*)ldsg; float* ks = qs + 64 * 128; float* as = ks + 64 * 128;
    float s[128];
#pragma unroll
    for (int i = 0; i < 128; ++i) s[i] = 0.f;
    for (int ci = 0; ci < 64; ++ci) {
        const int chunk = DIR ? 63 - ci : ci; const long row0 = (long)b * SEQ + chunk * 64;
        __syncthreads();
        { const int t = tid >> 3, g = tid & 7; const long row = row0 + t;
          const bf16_t* qp = gqkv + row * 2048 + h * 128 + g * 16; const bf16_t* kp = qp + 512;
          const int tp = DIR ? t + 1 : t - 1; const bool hasp = DIR ? (t < 63) : (t > 0);
          const _Float16* bp = bc + row * 512 + h * 128 + g * 16; const _Float16* bpp = bc + (row0 + (hasp ? tp : t)) * 512 + h * 128 + g * 16;
          float qf[16], kf[16];
          unpack8(*(const u32x4*)qp, qf); unpack8(*(const u32x4*)(qp + 8), qf + 8); unpack8(*(const u32x4*)kp, kf); unpack8(*(const u32x4*)(kp + 8), kf + 8);
          const f16x8 b0 = *(const f16x8*)bp, b1 = *(const f16x8*)(bp + 8), c0 = *(const f16x8*)bpp, c1 = *(const f16x8*)(bpp + 8);
#pragma unroll
          for (int j = 0; j < 16; ++j) {
              const float bb = (float)(j < 8 ? b0[j & 7] : b1[j & 7]), cc = hasp ? (float)(j < 8 ? c0[j & 7] : c1[j & 7]) : 0.f;
              qs[t * 128 + g * 16 + j] = qf[j] * GLA_QSCALE; ks[t * 128 + g * 16 + j] = kf[j]; as[t * 128 + g * 16 + j] = exp2f(bb - cc);
          } }
        __syncthreads();
        if (tid < 256) {
            for (int tt = 0; tt < 64; ++tt) {
                const int t = DIR ? 63 - tt : tt; const long row = row0 + t;
                const float v = bf2f(gqkv[row * 2048 + 1024 + h * 256 + tid]);
                float o = 0.f;
                const f32x4* q4 = (const f32x4*)(qs + t * 128); const f32x4* k4 = (const f32x4*)(ks + t * 128); const f32x4* a4 = (const f32x4*)(as + t * 128);
#pragma unroll
                for (int d4 = 0; d4 < 32; ++d4) { const f32x4 q = q4[d4], k = k4[d4], a = a4[d4];
#pragma unroll
                    for (int e = 0; e < 4; ++e) {
                        if (DIR == 0) { s[4 * d4 + e] = fmaf(s[4 * d4 + e], a[e], k[e] * v); o = fmaf(q[e], s[4 * d4 + e], o); }
                        else { const float sd = s[4 * d4 + e] * a[e]; o = fmaf(q[e], sd, o); s[4 * d4 + e] = fmaf(k[e], v, sd); } }
                    if ((d4 & 3) == 3) asm volatile("" ::: "memory"); }
                oo[row * 1024 + h * 256 + tid] = (bf16_t)(cvt_pk_bf16(o, 0.f) & 0xffffu);
            }
        }
    }
    __syncthreads();
}

DI void tr_item(const float* W, int ldw, int col0, int K, bf16_t* WT, int drow0, const float* gs, LAS float* scr, int item, int nblk, int lane, int ldt = 0) {
    if (ldt == 0) ldt = K;
    const int kb = item / nblk, nb = item - kb * nblk, k0 = 64 * kb, n0 = 32 * nb;
#pragma unroll
    for (int i = 0; i < 32; ++i) { const int kk = 2 * i + (lane >> 5); float w = W[(size_t)(k0 + kk) * ldw + col0 + n0 + (lane & 31)]; if (gs) w *= gs[k0 + kk]; scr[kk * 33 + (lane & 31)] = w; }
    LDS_WAIT(); asm volatile("" ::: "memory");
    const int c = lane & 7;
#pragma unroll
    for (int j = 0; j < 4; ++j) { const int n = (lane >> 3) + 8 * j; const LAS float* s = scr + (8 * c) * 33 + n;
        u32x4 o; o.x = cvt_pk_bf16(s[0 * 33], s[1 * 33]); o.y = cvt_pk_bf16(s[2 * 33], s[3 * 33]); o.z = cvt_pk_bf16(s[4 * 33], s[5 * 33]); o.w = cvt_pk_bf16(s[6 * 33], s[7 * 33]);
        const int ng = drow0 + n0 + n;
        if (ldt > 0) *(u32x4*)(WT + (size_t)ng * ldt + k0 + 8 * c) = o;
        else *(u32x4*)(WT + (((size_t)(ng >> 8) * (size_t)(-ldt) + kb) * 256 + (ng & 255)) * 64 + 8 * c) = o; }
    LDS_WAIT(); asm volatile("" ::: "memory");
}
DI float logsigmoidf_(float x) { return fminf(x, 0.f) - log1pf(expf(-fabsf(x))); }

#define XB_TMO      128
#define XB_XCNT(j)  (256  + 64 * (j))
#define XB_XSUB(j)  (1280 + 64 * (j))
#define XB_XGEN(j)  (2304 + 64 * (j))
#define XB_TOP      3328
#define XB_TOPGEN   3392
#define XCD_BAR_WORDS 3456
#define XB_SPIN_CAP (1u << 18)

__device__ __forceinline__ unsigned xb_ld(unsigned* p)              { return __hip_atomic_load(p, __ATOMIC_RELAXED, __HIP_MEMORY_SCOPE_AGENT); }
__device__ __forceinline__ unsigned xb_add(unsigned* p, unsigned v) { return __hip_atomic_fetch_add(p, v, __ATOMIC_RELAXED, __HIP_MEMORY_SCOPE_AGENT); }
__device__ __forceinline__ unsigned xb_xcc_id() { return (unsigned)__builtin_amdgcn_s_getreg((3 << 11) | 20) & 0xFu; }
#define XB_SPIN(cond, bar) do { unsigned _sp = 0; while (cond) { __builtin_amdgcn_s_sleep(1); \
    if ((++_sp & 255u) == 0u) { if (xb_ld(&(bar)[XB_TMO])) break; if (_sp > XB_SPIN_CAP) { atomicAdd(&(bar)[XB_TMO], 1u); break; } } } } while (0)

struct XcdBarrier {
    unsigned* bar; unsigned x;
    volatile LAS unsigned* st;
};

__device__ __forceinline__ XcdBarrier xcd_barrier_post(unsigned* bar, volatile LAS unsigned* st) {
    XcdBarrier b; b.bar = bar; b.x = xb_xcc_id(); b.st = st;
    if (threadIdx.x == 0) (void)xb_add(&bar[XB_XCNT(b.x)], 1u);
    return b;
}
__device__ __forceinline__ void xcd_barrier_complete(unsigned* bar, unsigned x, unsigned& nloc, unsigned& nx) {
    const unsigned G = gridDim.x * gridDim.y * gridDim.z;
    unsigned sum, cnt, mine, sp = 0u;
    for (;;) {
        sum = 0u; cnt = 0u; mine = 0u;
#pragma unroll
        for (unsigned j = 0; j < 16; ++j) { const unsigned c = xb_ld(&bar[XB_XCNT(j)]); sum += c; cnt += (c > 0u) ? 1u : 0u; mine = (j == x) ? c : mine; }
        if (sum == G) break;
        __builtin_amdgcn_s_sleep(1);
        if ((++sp & 255u) == 0u) { if (xb_ld(&bar[XB_TMO])) break; if (sp > XB_SPIN_CAP) { atomicAdd(&bar[XB_TMO], 1u); break; } }
    }
    nloc = mine > 0u ? mine : 1u; nx = cnt > 0u ? cnt : 1u;
}

__device__ __forceinline__ void xcd_barrier(const XcdBarrier& b) {
    asm volatile("s_waitcnt vmcnt(0)" ::: "memory");
    __syncthreads();
    if (threadIdx.x == 0) {
        unsigned* bar = b.bar;
        __builtin_amdgcn_s_waitcnt(0);
        unsigned nloc = b.st[0], nx = b.st[1];
        if (nloc == 0u) { xcd_barrier_complete(bar, b.x, nloc, nx); b.st[0] = nloc; b.st[1] = nx; }
        const unsigned old = xb_add(&bar[XB_XSUB(b.x)], 1u);
        const unsigned gen = old / nloc;
        if (old + 1u == (gen + 1u) * nloc) {
            __builtin_amdgcn_fence(__ATOMIC_RELEASE, "agent");
            asm volatile("s_waitcnt vmcnt(0)" ::: "memory");
            const unsigned og = xb_add(&bar[XB_TOP], 1u);
            const unsigned tg = og / nx;
            if (og + 1u == (tg + 1u) * nx) xb_add(&bar[XB_TOPGEN], 1u);
            else XB_SPIN(xb_ld(&bar[XB_TOPGEN]) == tg, bar);
            __builtin_amdgcn_fence(__ATOMIC_ACQUIRE, "agent");
            xb_add(&bar[XB_XGEN(b.x)], 1u);
            asm volatile("s_waitcnt vmcnt(0)" ::: "memory");
        } else {
            XB_SPIN(xb_ld(&bar[XB_XGEN(b.x)]) == gen, bar);
            __builtin_amdgcn_fence(__ATOMIC_ACQUIRE, "agent");
            asm volatile("s_waitcnt vmcnt(0)" ::: "memory");
        }
    }
    __syncthreads();
}

constexpr int NPHASE = 10;
__global__ void __launch_bounds__(NTHR, 2) fwd_megakernel(Args a) {
    extern __shared__ __attribute__((aligned(16))) unsigned char lds[];
    cg::grid_group grid = cg::this_grid();
    LAS unsigned char* ldsl = (LAS unsigned char*)lds;
    const int tid = threadIdx.x, lane = tid & 63, wave = __builtin_amdgcn_readfirstlane(tid >> 6);
    const int G = gridDim.x, bid = blockIdx.x;
    const int gw = bid * NWAVES + wave, NGW = G * NWAVES; const long gt = (long)bid * NTHR + tid, NGT = (long)G * NTHR;
#define WSP(T_, off) ((T_*)(a.ws + (off)))
#define WinA WSP(bf16_t, WS_WINA)
#define WinB WSP(bf16_t, WS_WINB)
#define Wuq WSP(bf16_t, WS_WUQ)
#define Wukv WSP(bf16_t, WS_WUKV)
#define Wout WSP(bf16_t, WS_WOUT)
#define W1 WSP(bf16_t, WS_W1)
#define W2 WSP(bf16_t, WS_W2)
#define ropec WSP(float, WS_ROPEC)
#define ropes WSP(float, WS_ROPES)
#define ssq_q WSP(float, WS_SSQ)
#define ssq_kv (WSP(float, WS_SSQ) + T)
#define ssq_h (WSP(float, WS_SSQ) + 2 * T)
#define ssq_h2 (WSP(float, WS_SSQ) + 3 * T)
#define ctl WSP(int, WS_CTL)
#define XN WSP(bf16_t, WS_XN)
#define MERGED WSP(bf16_t, WS_MERGED)
#define GQKV WSP(bf16_t, WS_GQKV)
#define KB WSP(bf16_t, WS_K)
#define VB WSP(bf16_t, WS_V)
#define GATES WSP(bf16_t, WS_GATES)
#define UB WSP(bf16_t, WS_U)
#define QO WSP(bf16_t, WS_QO)
#define SMALL WSP(bf16_t, WS_SMALL)
#define OB WSP(bf16_t, WS_OB)
#define HB WSP(bf16_t, WS_HB)
#define BCF ((_Float16*)a.out)
#define BCB ((_Float16*)a.out + (size_t)T * 512)
#define OF ((bf16_t*)((unsigned char*)a.out + 64 * MiB))
    const int lo = a.ph_lo, hi_ = a.ph_hi;
    LAS int* misc = (LAS int*)(ldsl + LDS_MISC);
    if (tid == 0) { const int x = (int)(__builtin_amdgcn_s_getreg((3 << 11) | 20) & 0xFu); misc[0] = x; misc[1] = atomicAdd(ctl + 16 + x, 1); }
    if (tid == 0) { misc[8] = 0; misc[9] = 0; }
    __syncthreads();
    int cvirt = bid;
    const XcdBarrier xbar = xcd_barrier_post((unsigned*)(ctl + 1024), (volatile LAS unsigned*)(misc + 8));
#ifndef DBG_MASK
#define DBG_MASK 0x3ff
#endif
#define IN(k) (lo <= (k) && (k) < hi_ && ((DBG_MASK >> (k)) & 1))
#define SEAM(k) do { if (IN(k) && IN((k) + 1)) xcd_barrier(xbar); } while (0)

    if (IN(0)) {
        LAS float* scr = (LAS float*)(ldsl + wave * 16384);
        constexpr int J0 = 16 * 64, J1 = 16 * 22, J4 = 6 * 24, J5 = 4 * 48;
        constexpr int NITEMS = J0 + J1 + J4 + J5;
        for (int it = gw; it < NITEMS; it += NGW) {
            int r = it;
            if (r < J0) { tr_item(a.w_in, 5824, 0, 1024, WinA, 0, nullptr, scr, r, 64, lane); continue; } r -= J0;
            if (r < J1) { tr_item(a.w_in, 5824, 3072, 1024, WinA, 2048, nullptr, scr, r, 22, lane); continue; } r -= J1;
            if (r < J4) { tr_item(a.w_uq, 768, 0, 384, Wuq, 0, a.g_q, scr, r, 24, lane); continue; } r -= J4;
            tr_item(a.w_ukv, 1536, 0, 256, Wukv, 0, a.g_kv, scr, r, 48, lane);
        }
        for (long i = gt; i < 64 * 1024 / 8; i += NGT) *(u32x4*)(WinA + (size_t)2752 * 1024 + i * 8) = (u32x4){0u, 0u, 0u, 0u};
        for (int m0 = gw; m0 < T; m0 += 4 * NGW) {
            const f32x4* gr = (const f32x4*)a.g_mix + lane; f32x4 v[4][4];
#pragma unroll
            for (int k = 0; k < 4; ++k) { const int m = m0 + k * NGW; if (m < T) { const f32x4* xr = (const f32x4*)(a.x + (size_t)m * DM) + lane;
#pragma unroll
                for (int j = 0; j < 4; ++j) v[k][j] = __builtin_nontemporal_load(xr + 64 * j); } }
#pragma unroll
            for (int k = 0; k < 4; ++k) { const int m = m0 + k * NGW; if (m < T) { float s2 = 0.f;
#pragma unroll
                for (int j = 0; j < 4; ++j) s2 += (v[k][j].x * v[k][j].x + v[k][j].y * v[k][j].y) + (v[k][j].z * v[k][j].z + v[k][j].w * v[k][j].w);
                const float rstd = rsqrtf(wave_sum(s2) * (1.f / DM) + EPS);
                u32x2* o8 = (u32x2*)(XN + (size_t)m * DM) + lane;
#pragma unroll
                for (int j = 0; j < 4; ++j) { const f32x4 g = gr[64 * j]; const f32x4 w = v[k][j] * rstd * g; u32x2 p; p.x = cvt_pk_bf16(w.x, w.y); p.y = cvt_pk_bf16(w.z, w.w); o8[64 * j] = p; } } }
        }
        for (long i = gt; i < (long)T * 16; i += NGT) {
            const int t = (int)(i >> 4), k = (int)(i & 15);
            const float inv = exp2f(-(float)k * (13.287712379549449f / 16.0f)); const float ang = (float)a.pos[t] * inv;
            float sn, cs; sincosf(ang, &sn, &cs); ropec[i] = cs; ropes[i] = sn;
        }
        for (long i = gt; i < (long)T * 4; i += NGT) ssq_q[i] = 0.f;
    }
    SEAM(0);
    if (IN(0) && IN(1) && (G & 7) == 0) {
        bool ok = misc[0] < 8;
#pragma unroll
        for (int j = 0; j < 8; ++j) ok = ok && (__hip_atomic_load(ctl + 16 + j, __ATOMIC_RELAXED, __HIP_MEMORY_SCOPE_AGENT) == (G >> 3));
        if (ok) cvirt = misc[1] * 8 + misc[0];
    }
    if (IN(1)) {
        pg8::Gemm g{XN, WinA, T, NA, DM, DM, DM}; pg8::StaticOrder S; S.init(T, NA, G, cvirt);
        EpiP1a E{GQKV, SMALL, ssq_q, ssq_kv};
        pg8::gemm_phase<EpiP1a, pg8::StaticOrder, true, true>(ldsl, g, S, E);
    }
    SEAM(1);
    if (IN(2)) {
#ifndef DBG_P2
#define DBG_P2 15
#endif
        { pg8::Gemm g{SMALL + 32, Wuq, T, 768, 384, LDSM, 384}; pg8::StaticOrder S; S.init(T, 768, G, cvirt);
          EpiQ E{QO, ssq_q, ropec, ropes};
          pg8::gemm_phase<EpiQ, pg8::StaticOrder, true, true>(ldsl, g, S, E); }
        { pg8::Gemm g{SMALL + 416, Wukv, T, 1536, 256, LDSM, 256}; pg8::StaticOrder S; S.init(T, 1536, G, cvirt);
          EpiKV E{KB, VB, ssq_kv};
          pg8::gemm_phase<EpiKV, pg8::StaticOrder, true, true>(ldsl, g, S, E); }
        for (long i = gt; i < (long)T * 8; i += NGT) {
            const long t = i >> 3; const int h = (int)(i & 7);
            float x[32], c[16], sn[16];
            const bf16_t* kp = SMALL + t * LDSM + 672;
            unpack8(*(const u32x4*)kp, x); unpack8(*(const u32x4*)(kp + 8), x + 8); unpack8(*(const u32x4*)(kp + 16), x + 16); unpack8(*(const u32x4*)(kp + 24), x + 24);
#pragma unroll
            for (int q = 0; q < 4; ++q) { const f32x4 cv = *(const f32x4*)(ropec + t * 16 + 4 * q), sv = *(const f32x4*)(ropes + t * 16 + 4 * q);
                c[4 * q] = cv[0]; c[4 * q + 1] = cv[1]; c[4 * q + 2] = cv[2]; c[4 * q + 3] = cv[3]; sn[4 * q] = sv[0]; sn[4 * q + 1] = sv[1]; sn[4 * q + 2] = sv[2]; sn[4 * q + 3] = sv[3]; }
            float o[32];
#pragma unroll
            for (int k = 0; k < 16; ++k) { o[k] = x[k] * c[k] - x[16 + k] * sn[k]; o[16 + k] = x[k] * sn[k] + x[16 + k] * c[k]; }
            bf16_t* dst = KB + t * 768 + h * 96 + 64;
#pragma unroll
            for (int q = 0; q < 4; ++q) { u32x4 w; w.x = cvt_pk_bf16(o[8 * q], o[8 * q + 1]); w.y = cvt_pk_bf16(o[8 * q + 2], o[8 * q + 3]); w.z = cvt_pk_bf16(o[8 * q + 4], o[8 * q + 5]); w.w = cvt_pk_bf16(o[8 * q + 6], o[8 * q + 7]);
                *(u32x4*)(dst + 8 * q) = w; }
        }
        for (int unit = bid; unit < T / 64; unit += G) {
            float* zs = (float*)lds; const long row0 = (long)unit * 64;
            __syncthreads();
            { const int t = tid >> 3, c4 = (tid & 7) * 4; const u32x2 w = *(const u32x2*)(SMALL + (row0 + t) * LDSM + c4);
              zs[t * 32 + c4] = bflo(w.x); zs[t * 32 + c4 + 1] = bfhi(w.x); zs[t * 32 + c4 + 2] = bflo(w.y); zs[t * 32 + c4 + 3] = bfhi(w.y); }
            __syncthreads();
            float wf[16], wb[16];
#pragma unroll
            for (int r = 0; r < 16; ++r) { wf[r] = a.w_gate_f[r * 512 + tid]; wb[r] = a.w_gate_b[r * 512 + tid]; }
            const float bf_ = a.b_gate_f[tid], bb_ = a.b_gate_b[tid];
            float run = 0.f;
            for (int t = 0; t < 64; ++t) { float pre = bf_;
#pragma unroll
                for (int r = 0; r < 16; ++r) pre = fmaf(zs[t * 32 + r], wf[r], pre);
                run += logsig2_(pre) * (1.0f / 16.0f); BCF[(row0 + t) * 512 + tid] = (_Float16)run; }
            run = 0.f;
            for (int t = 63; t >= 0; --t) { float pre = bb_;
#pragma unroll
                for (int r = 0; r < 16; ++r) pre = fmaf(zs[t * 32 + 16 + r], wb[r], pre);
                run += logsig2_(pre) * (1.0f / 16.0f); BCB[(row0 + t) * 512 + tid] = (_Float16)run; }
        }
        __syncthreads();
    }
    SEAM(2);
    if (IN(3)) {
        LAS int* sidx = (LAS int*)(ldsl + LDS_MISC + 64);
#define FETCH(dst) do { __syncthreads(); if (tid == 0) *sidx = atomicAdd(ctl, 1); __syncthreads(); dst = *sidx; } while (0)
        int idx; FETCH(idx);
#ifndef DBG_NOGLA
        while (idx < 64) {
            const int b = idx >> 3, h = (idx >> 1) & 3;
#ifdef GLA_NAIVE
            if (idx & 1) gla_naive_unit<1>(b, h, GQKV, BCB, OB, lds); else gla_naive_unit<0>(b, h, GQKV, BCF, OF, lds);
#else
            if (idx & 1) gla::unit<1>(b, h, GQKV, BCB, OB, (char*)lds); else gla::unit<0>(b, h, GQKV, BCF, OF, (char*)lds);
#endif
            FETCH(idx);
        }
#endif
#ifndef DBG_NOATT
        while (idx < 64 + 1024) {
            const int u = idx - 64, bh = u >> 4, qb = u & 15, b = bh >> 3, h = bh & 7;
            const size_t rowq = (size_t)b * SEQ + qb * 256, rowk = (size_t)b * SEQ;
            att::attn_dense_body(QO + rowq * 1024 + h * 128, KB + rowk * 768 + h * 96, VB + rowk * 1024 + h * 128, QO + rowq * 1024 + h * 128, SEQ, (char*)lds);
            FETCH(idx);
        }
#endif
        {
            constexpr int J2 = 16 * 32, J3 = 16 * 64, J6 = 16 * 32, J7 = 16 * 128, J8 = 64 * 32, NLATE = J2 + J3 + J6 + J7 + J8, NFILL = NLATE / 16;
            static_assert(NLATE % 16 == 0, "filler units are 16 items each");
            LAS float* scr = (LAS float*)(ldsl + wave * 16384);
            while (idx < 64 + 1024 + NFILL) {
                const int base = (idx - (64 + 1024)) * 16 + wave * 2;
                for (int q = 0; q < 2; ++q) {
                    int r = base + q;
                    if (r < J2) { tr_item(a.w_in, 5824, 2048, 1024, WinB, 0, nullptr, scr, r, 32, lane); continue; } r -= J2;
                    if (r < J3) { tr_item(a.w_in, 5824, 3776, 1024, WinB, 1024, nullptr, scr, r, 64, lane); continue; } r -= J3;
                    if (r < J6) { tr_item(a.w_out, 1024, 0, 1024, Wout, 0, nullptr, scr, r, 32, lane); continue; } r -= J6;
                    if (r < J7) { tr_item(a.w_ff1, 4096, 0, 1024, W1, 0, a.g_mlp, scr, r, 128, lane); continue; } r -= J7;
                    tr_item(a.w_ff2, 1024, 0, 4096, W2, 0, nullptr, scr, r, 32, lane, -(DFF / 64));
                }
                FETCH(idx);
            }
        }
#undef FETCH
    }
    SEAM(3);
    if (IN(4)) {
        pg8::Gemm g{XN, WinB, T, NG, DM, DM, DM}; pg8::StaticOrder S; S.init(T, NG, G, cvirt);
        EpiGates E{GATES};
        pg8::gemm_phase<EpiGates, pg8::StaticOrder, true, true>(ldsl, g, S, E);
    }
    SEAM(4);
    if (IN(5)) {
        for (int m0 = gw; m0 < T; m0 += 2 * NGW) {
            u32x4 ld[2][12];
#pragma unroll
            for (int k = 0; k < 2; ++k) { const int m = m0 + k * NGW; if (m < T) { const size_t r1 = (size_t)m * 1024 + lane * 8; const bf16_t* gp = GATES + (size_t)m * NG + lane * 8;
#pragma unroll
                for (int j = 0; j < 2; ++j) { ld[k][6 * j + 0] = __builtin_nontemporal_load((const u32x4*)(OF + r1 + 512 * j)); ld[k][6 * j + 1] = __builtin_nontemporal_load((const u32x4*)(OB + r1 + 512 * j)); ld[k][6 * j + 2] = __builtin_nontemporal_load((const u32x4*)(QO + r1 + 512 * j));
                    ld[k][6 * j + 3] = __builtin_nontemporal_load((const u32x4*)(gp + 512 * j)); ld[k][6 * j + 4] = __builtin_nontemporal_load((const u32x4*)(gp + 1024 + 512 * j)); ld[k][6 * j + 5] = __builtin_nontemporal_load((const u32x4*)(gp + 2048 + 512 * j)); } } }
            f32x4 gg[2][2];
#pragma unroll
            for (int j = 0; j < 2; ++j) { gg[j][0] = *(const f32x4*)(a.g_gla + lane * 8 + 512 * j); gg[j][1] = *(const f32x4*)(a.g_gla + lane * 8 + 512 * j + 4); }
#pragma unroll
            for (int k = 0; k < 2; ++k) { const int m = m0 + k * NGW; if (m < T) { const size_t r1 = (size_t)m * 1024 + lane * 8;
#pragma unroll
                for (int j = 0; j < 2; ++j) {
                    float of[8], ob[8], ym[8], gr[8], za[8], zb[8];
                    unpack8(ld[k][6 * j + 0], of); unpack8(ld[k][6 * j + 1], ob); unpack8(ld[k][6 * j + 2], ym); unpack8(ld[k][6 * j + 3], gr); unpack8(ld[k][6 * j + 4], za); unpack8(ld[k][6 * j + 5], zb);
                    float s2 = 0.f;
#pragma unroll
                    for (int e = 0; e < 8; ++e) { of[e] += ob[e]; s2 += of[e] * of[e]; }
                    s2 += __shfl_xor(s2, 1); s2 += __shfl_xor(s2, 2); s2 += __shfl_xor(s2, 4); s2 += __shfl_xor(s2, 8); s2 += __shfl_xor(s2, 16);
                    const float rstd = rsqrtf(s2 * (1.f / 256.f) + EPS);
                    float res[8];
#pragma unroll
                    for (int e = 0; e < 8; ++e) { const float y = of[e] * rstd * gg[j][e >> 2][e & 3] * gr[e]; res[e] = za[e] * y + zb[e] * ym[e]; }
                    u32x4 w; w.x = cvt_pk_bf16(res[0], res[1]); w.y = cvt_pk_bf16(res[2], res[3]); w.z = cvt_pk_bf16(res[4], res[5]); w.w = cvt_pk_bf16(res[6], res[7]);
                    *(u32x4*)(MERGED + r1 + 512 * j) = w; } } }
        }
    }
    SEAM(5);
    if (IN(6)) {
        pg8::Gemm g{MERGED, Wout, T, DM, DM, DM, DM}; pg8::StaticOrder S; S.init(T, DM, G, cvirt);
        EpiResB<false> E{a.x, HB, ssq_h};
        pg8::gemm_phase<EpiResB<false>, pg8::StaticOrder, true, true>(ldsl, g, S, E);
    }
    SEAM(6);
    if (IN(7)) {
        pg8::Gemm g{HB, W1, T, DFF, DM, DM, DM}; pg8::StaticOrder S; S.init(T, DFF, G, cvirt);
        EpiFF1 E{UB, ssq_h};
        pg8::gemm_phase<EpiFF1, pg8::StaticOrder, true, true>(ldsl, g, S, E);
    }
    SEAM(7);
    if (IN(8)) {
        pg8::Gemm g{UB, W2, T, DM, DFF, 64, 64, 256u * 64u * 2u, (unsigned)(DFF / 64) * 256u * 64u * 2u, 256u * 64u * 2u, (unsigned)(DFF / 64) * 256u * 64u * 2u}; pg8::ReverseOrder S; S.init(T, DM, G, cvirt);
        EpiResB<true> E{HB, MERGED, nullptr};
        pg8::gemm_phase<EpiResB<true>, pg8::ReverseOrder, true, true>(ldsl, g, S, E);
    }
    SEAM(8);
    if (IN(9)) {
        for (int m0 = gw; m0 < T; m0 += 8 * NGW) {
            u32x2 v[8][4];
#pragma unroll
            for (int k = 0; k < 8; ++k) { const int m = m0 + k * NGW; if (m < T) { const u32x2* hp = (const u32x2*)(MERGED + (size_t)m * DM) + lane;
#pragma unroll
                for (int j = 0; j < 4; ++j) v[k][j] = hp[64 * j]; } }
            f32x4 g4[4];
#pragma unroll
            for (int j = 0; j < 4; ++j) g4[j] = ((const f32x4*)a.g_final)[lane + 64 * j];
#pragma unroll
            for (int k = 0; k < 8; ++k) { const int m = m0 + k * NGW; if (m < T) {
                float s2 = 0.f;
#pragma unroll
                for (int j = 0; j < 4; ++j) { const float f0 = bflo(v[k][j].x), f1 = bfhi(v[k][j].x), f2 = bflo(v[k][j].y), f3 = bfhi(v[k][j].y); s2 += (f0 * f0 + f1 * f1) + (f2 * f2 + f3 * f3); }
                const float rstd = rsqrtf(wave_sum(s2) * (1.f / DM) + EPS); f32x4* op = (f32x4*)(a.out + (size_t)m * DM) + lane;
#pragma unroll
                for (int j = 0; j < 4; ++j) __builtin_nontemporal_store((f32x4){bflo(v[k][j].x), bfhi(v[k][j].x), bflo(v[k][j].y), bfhi(v[k][j].y)} * rstd * g4[j], op + 64 * j); } }
        }
    }
    if (a.ph_hi > NPHASE) grid.sync();
#undef IN
#undef SEAM
}

#ifndef MK_PER_PHASE
#define MK_PER_PHASE 0
#endif
extern "C" void kernel_launch(void* const* d_in, const int* in_sizes, int n_in, void* d_out, int out_size, void* d_ws, size_t ws_size, hipStream_t stream) {
    static int grid = 0;
    if (grid == 0) {
        if (n_in != 18 || in_sizes[0] != T * DM || out_size != T * DM || ws_size < WS_END) { fprintf(stderr, "kernel_launch: unexpected shapes (n_in %d in0 %d out %d ws %zu)\n", n_in, n_in > 0 ? in_sizes[0] : -1, out_size, ws_size); grid = -1; return; }
        int dev = 0, cus = 0, per_cu = 0;
        hipGetDevice(&dev); hipDeviceGetAttribute(&cus, hipDeviceAttributeMultiprocessorCount, dev);
        if (hipFuncSetAttribute((const void*)fwd_megakernel, hipFuncAttributeMaxDynamicSharedMemorySize, LDS_BYTES) != hipSuccess) { fprintf(stderr, "kernel_launch: hipFuncSetAttribute failed\n"); grid = -1; return; }
        if (hipOccupancyMaxActiveBlocksPerMultiprocessor(&per_cu, (const void*)fwd_megakernel, NTHR, LDS_BYTES) != hipSuccess || per_cu < 1) { fprintf(stderr, "kernel_launch: occupancy query says %d\n", per_cu); per_cu = 1; }
        (void)hipGetLastError();
        grid = cus * 1;
    }
    if (grid < 0) return;
    if (hipMemsetAsync((char*)d_ws + WS_CTL, 0, 32768, stream) != hipSuccess) { fprintf(stderr, "kernel_launch: memset failed\n"); return; }
    Args a{};
    a.x = (const float*)d_in[0]; a.pos = (const int*)d_in[1]; a.g_mix = (const float*)d_in[2]; a.w_in = (const float*)d_in[3]; a.w_gate_f = (const float*)d_in[4]; a.b_gate_f = (const float*)d_in[5];
    a.w_gate_b = (const float*)d_in[6]; a.b_gate_b = (const float*)d_in[7]; a.g_gla = (const float*)d_in[8]; a.g_q = (const float*)d_in[9]; a.w_uq = (const float*)d_in[10]; a.g_kv = (const float*)d_in[11];
    a.w_ukv = (const float*)d_in[12]; a.w_out = (const float*)d_in[13]; a.g_mlp = (const float*)d_in[14]; a.w_ff1 = (const float*)d_in[15]; a.w_ff2 = (const float*)d_in[16]; a.g_final = (const float*)d_in[17];
    a.out = (float*)d_out; a.ws = (unsigned char*)d_ws;
#if MK_PER_PHASE
    for (int p = 0; p < NPHASE; ++p) { a.ph_lo = p; a.ph_hi = p + 1; hipLaunchKernelGGL(fwd_megakernel, dim3(grid), dim3(NTHR), LDS_BYTES, stream, a); }
#else
    a.ph_lo = 0; a.ph_hi = NPHASE;
    void* args[] = {&a};
    hipError_t e = hipLaunchCooperativeKernel((const void*)fwd_megakernel, dim3(grid), dim3(NTHR), args, LDS_BYTES, stream);
    if (e != hipSuccess) fprintf(stderr, "kernel_launch: cooperative launch failed: %s (grid %d)\n", hipGetErrorString(e), grid);
#endif
}
```

```cpp
#include <hip/hip_runtime.h>
#include <hip/hip_cooperative_groups.h>
#include <cstdio>
#include <cstdint>
namespace cg = cooperative_groups;

typedef unsigned short bf16_t;
typedef short bf16x8 __attribute__((ext_vector_type(8)));
typedef short s16x4 __attribute__((ext_vector_type(4)));
typedef float f32x2 __attribute__((ext_vector_type(2)));
typedef float f32x4 __attribute__((ext_vector_type(4)));
typedef float f32x8 __attribute__((ext_vector_type(8)));
typedef float f32x16 __attribute__((ext_vector_type(16)));
typedef unsigned u32x2 __attribute__((ext_vector_type(2)));
typedef unsigned u32x4 __attribute__((ext_vector_type(4)));
typedef _Float16 f16x8 __attribute__((ext_vector_type(8)));
#define DI __device__ __forceinline__
typedef __bf16 bf16x2_t __attribute__((ext_vector_type(2)));
DI unsigned cvt_pk_bf16(float lo, float hi) { f32x2 v = {lo, hi}; bf16x2_t b = __builtin_convertvector(v, bf16x2_t); return __builtin_bit_cast(unsigned, b); }
DI float bf2f(unsigned short b) { return __uint_as_float((unsigned)b << 16); }
DI float bflo(unsigned w) { return __uint_as_float(w << 16); }
DI float bfhi(unsigned w) { return __uint_as_float(w & 0xffff0000u); }
DI u32x4 pack8(const f32x4 a, const f32x4 b) { u32x4 w; w.x = cvt_pk_bf16(a[0], a[1]); w.y = cvt_pk_bf16(a[2], a[3]); w.z = cvt_pk_bf16(b[0], b[1]); w.w = cvt_pk_bf16(b[2], b[3]); return w; }
DI void unpack8(const u32x4 w, float* f) { f[0] = bflo(w.x); f[1] = bfhi(w.x); f[2] = bflo(w.y); f[3] = bfhi(w.y); f[4] = bflo(w.z); f[5] = bfhi(w.z); f[6] = bflo(w.w); f[7] = bfhi(w.w); }

namespace pg8 {
#define PG8_LAS __attribute__((address_space(3)))
constexpr int BM = 256, BK = 64, HALF = 128, HTB = HALF * BK * 2  , STAGE_BYTES = 8 * HTB, NXCD = 8, WGM = 8;
__host__ __device__ __forceinline__ int lds_byte(int r, int c) { const int st = (r >> 4) * 2 + (c >> 5), rr = r & 15, cc = c & 31, ob = rr * 64 + cc * 2; return st * 1024 + (ob ^ (((ob >> 9) & 1) << 5)); }
__host__ __device__ __forceinline__ void stage_rc(int b, int& R, int& C) { const int st = b / 1024, sb = b % 1024, swz = sb ^ (((sb >> 9) & 1) << 5); R = (st >> 1) * 16 + swz / 64; C = (st & 1) * 32 + (swz % 64) / 2; }
__host__ __device__ __forceinline__ int perm32(int rho) { const int n = rho >> 4, i = rho & 15; return 8 * (i >> 2) + 4 * n + (i & 3); }
struct Unit { int pm, pn; };
struct Gemm { const bf16_t* A; const bf16_t* Bt; int M, N, K, lda, ldb; unsigned akstep = 0, atstep = 0, bkstep = 0, btstep = 0; };
struct StaticOrder {
    int nM, nN, nwg, G, c;
    __host__ __device__ void init(int M, int N, int G_, int c_) { nM = M / BM; nN = N / BM; nwg = nM * nN; G = G_; c = c_; }
    __host__ __device__ bool next(int i, Unit& u) const {
        const long L = (long)i * G + c; if (L >= nwg) return false;
        int wgid = (int)L; { const int q = nwg / NXCD, r = nwg % NXCD, xcd = wgid % NXCD, off = wgid / NXCD; wgid = (xcd < r ? xcd * (q + 1) : r * (q + 1) + (xcd - r) * q) + off; }
        const int nig = WGM * nN, gid = wgid / nig, fm = gid * WGM, gsz = (nM - fm) < WGM ? (nM - fm) : WGM;
        u.pm = fm + ((wgid % nig) % gsz); u.pn = (wgid % nig) / gsz; return true;
    }
    __device__ __forceinline__ void a_ready(const Unit&) const {}
    __device__ __forceinline__ void done(const Unit&) const {}
};
struct ReverseOrder {
    StaticOrder S; int nr; bool rev;
    __host__ __device__ void init(int M, int N, int G_, int c_) { S.init(M, N, G_, c_); nr = S.nwg / G_; rev = (nr * G_ == S.nwg); }
    __host__ __device__ bool next(int i, Unit& u) const { if (!rev) return S.next(i, u); if (i >= nr) return false; return S.next(nr - 1 - i, u); }
    __device__ __forceinline__ void a_ready(const Unit&) const {}
    __device__ __forceinline__ void done(const Unit&) const {}
};
template <class Epi, class Sched, bool ALIGN_EPI = false, bool SP2 = false>
__device__ __forceinline__ void gemm_phase(PG8_LAS unsigned char* lds, const Gemm g, const Sched& S, const Epi& E) {
    const int tid = threadIdx.x, wid = __builtin_amdgcn_readfirstlane(tid >> 6), lane = tid & 63, wr = wid >> 2, wc = wid & 3, fr = lane & 15, fq = lane >> 4;
    int nt = g.K / BK; asm volatile("" : "+s"(nt));
    unsigned voffA[2], voffB[2];
#pragma unroll
    for (int i = 0; i < 2; ++i) { int R, C; stage_rc(tid * 16 + i * 8192, R, C); const int Rb = Epi::PERM ? ((R & ~31) + perm32(R & 31)) : R;
        voffA[i] = (unsigned)(R * g.lda + C) * 2u; voffB[i] = (unsigned)(Rb * g.ldb + C) * 2u; }
    const size_t kstep = (size_t)(BK * 2);
    const size_t kstepA = g.akstep ? (size_t)g.akstep : kstep, kstepB = g.bkstep ? (size_t)g.bkstep : kstep;
    const size_t hstepA = (size_t)HALF * g.lda * 2, hstepB = (size_t)HALF * g.ldb * 2;
    const size_t tstepA = g.atstep ? (size_t)g.atstep : 2 * hstepA, tstepB = g.btstep ? (size_t)g.btstep : 2 * hstepB;
    const unsigned ldsw = (unsigned)wid * 1024u;
    const int aoff = lds_byte(wr * 64 + fr, fq * 8), boff = lds_byte(wc * 32 + fr, fq * 8);
#define PG8_SA(b, h) (((b) * 2 + (h)) * HTB)
#define PG8_SB(b, h) ((4 + (b) * 2 + (h)) * HTB)
#define PG8_STAGE(bufoff, gbase, voff) do { _Pragma("unroll") for (int _i = 0; _i < 2; ++_i) \
        __builtin_amdgcn_global_load_lds((const unsigned*)((const char*)(gbase) + (voff)[_i]), (PG8_LAS unsigned*)(lds + (bufoff) + ldsw + _i * 8192), 16, 0, 0); } while (0)
#define PG8_LDA(dst, b, h) do { _Pragma("unroll") for (int m = 0; m < 4; ++m) _Pragma("unroll") for (int k = 0; k < 2; ++k) dst[m][k] = *(const PG8_LAS bf16x8*)(lds + PG8_SA(b, h) + aoff + m * 2048 + k * 1024); } while (0)
#define PG8_LDB(dst, b, h) do { _Pragma("unroll") for (int n = 0; n < 2; ++n) _Pragma("unroll") for (int k = 0; k < 2; ++k) dst[n][k] = *(const PG8_LAS bf16x8*)(lds + PG8_SB(b, h) + boff + n * 2048 + k * 1024); } while (0)
#define PG8_MMA(ai, bj, At, Bt) do { __builtin_amdgcn_s_setprio(1); _Pragma("unroll") for (int m = 0; m < 4; ++m) _Pragma("unroll") for (int n = 0; n < 2; ++n) _Pragma("unroll") for (int k = 0; k < 2; ++k) \
        acc[ai][bj][m][n] = __builtin_amdgcn_mfma_f32_16x16x32_bf16(Bt[n][k], At[m][k], acc[ai][bj][m][n], 0, 0, 0); __builtin_amdgcn_s_setprio(0); } while (0)
#define PG8_WAIT_V(n) asm volatile("s_waitcnt vmcnt(" #n ")" ::: "memory")
#define PG8_WAIT_L(n) asm volatile("s_waitcnt lgkmcnt(" #n ")" ::: "memory")
#define PG8_BAR __builtin_amdgcn_s_barrier()
#define PG8_SCHED __builtin_amdgcn_sched_barrier(0)
    Unit cur, nxt; int ui = 0;
    if (!S.next(0, cur)) return;
    f32x4 acc[2][2][4][2];
#pragma unroll
    for (int a = 0; a < 2; ++a)
#pragma unroll
        for (int b = 0; b < 2; ++b)
#pragma unroll
            for (int m = 0; m < 4; ++m)
#pragma unroll
                for (int n = 0; n < 2; ++n) acc[a][b][m][n] = (f32x4){0.f, 0.f, 0.f, 0.f};
    bf16x8 At[4][2], B0[2][2], B1[2][2];
    const char* cA = (const char*)g.A + (size_t)cur.pm * tstepA; const char* cB = (const char*)g.Bt + (size_t)cur.pn * tstepB;
    S.a_ready(cur);
    if constexpr (SP2) {
        PG8_STAGE(PG8_SB(0, 0), cB, voffB); PG8_STAGE(PG8_SB(0, 1), cB + hstepB, voffB); PG8_STAGE(PG8_SA(0, 0), cA, voffA); PG8_STAGE(PG8_SA(0, 1), cA + hstepA, voffA);
        if (wr == 1) PG8_BAR;
        PG8_WAIT_V(2); PG8_BAR;
        PG8_STAGE(PG8_SB(1, 0), cB + kstepB, voffB); PG8_STAGE(PG8_SA(1, 0), cA + kstepA, voffA); PG8_STAGE(PG8_SB(1, 1), cB + hstepB + kstepB, voffB);
        PG8_WAIT_V(6); PG8_BAR;
    } else {
        PG8_STAGE(PG8_SB(0, 0), cB, voffB); PG8_STAGE(PG8_SA(0, 0), cA, voffA); PG8_STAGE(PG8_SB(0, 1), cB + hstepB, voffB); PG8_STAGE(PG8_SA(0, 1), cA + hstepA, voffA);
        if (wr == 1) PG8_BAR;
        PG8_WAIT_V(4); PG8_BAR;
        PG8_STAGE(PG8_SB(1, 0), cB + kstepB, voffB); PG8_STAGE(PG8_SA(1, 0), cA + kstepA, voffA); PG8_STAGE(PG8_SB(1, 1), cB + hstepB + kstepB, voffB);
        PG8_WAIT_V(6); PG8_BAR;
    }
    for (;;) {
        const bool has_next = S.next(ui + 1, nxt);
        const char* nA = has_next ? (const char*)g.A + (size_t)nxt.pm * tstepA : cA; const char* nB = has_next ? (const char*)g.Bt + (size_t)nxt.pn * tstepB : cB;
        for (int t = 0; t < nt; t += 2) {
            const bool last = (t == nt - 2);
            const char* a1 = cA + (size_t)(t + 1) * kstepA;
            const char* a2 = last ? nA : cA + (size_t)(t + 2) * kstepA; const char* b2 = last ? nB : cB + (size_t)(t + 2) * kstepB;
            const char* a3 = a2 + kstepA; const char* b3 = b2 + kstepB;
            if (last && has_next) S.a_ready(nxt);
            if constexpr (SP2) {
            PG8_LDB(B0, 0, 0); PG8_LDB(B1, 0, 1); PG8_SCHED; PG8_LDA(At, 0, 0); PG8_STAGE(PG8_SA(1, 1), a1 + hstepA, voffA);
            PG8_WAIT_V(8); PG8_WAIT_L(0); PG8_BAR; PG8_MMA(0, 0, At, B0); PG8_MMA(0, 1, At, B1); PG8_BAR; PG8_SCHED;
            PG8_LDA(At, 0, 1); PG8_STAGE(PG8_SB(0, 0), b2, voffB); PG8_STAGE(PG8_SB(0, 1), b2 + hstepB, voffB); PG8_STAGE(PG8_SA(0, 0), a2, voffA);
            PG8_WAIT_V(8); PG8_WAIT_L(0); PG8_BAR; PG8_MMA(1, 0, At, B0); PG8_MMA(1, 1, At, B1); PG8_BAR; PG8_SCHED;
            PG8_LDB(B0, 1, 0); PG8_LDB(B1, 1, 1); PG8_SCHED; PG8_LDA(At, 1, 0); PG8_STAGE(PG8_SA(0, 1), a2 + hstepA, voffA);
            PG8_WAIT_V(8); PG8_WAIT_L(0); PG8_BAR; PG8_MMA(0, 0, At, B0); PG8_MMA(0, 1, At, B1); PG8_BAR; PG8_SCHED;
            PG8_LDA(At, 1, 1); PG8_STAGE(PG8_SB(1, 0), b3, voffB); PG8_STAGE(PG8_SB(1, 1), b3 + hstepB, voffB); PG8_STAGE(PG8_SA(1, 0), a3, voffA);
            PG8_WAIT_V(8); PG8_WAIT_L(0); PG8_BAR; PG8_MMA(1, 0, At, B0); PG8_MMA(1, 1, At, B1); PG8_BAR; PG8_SCHED;
            } else {
            PG8_LDB(B0, 0, 0); PG8_SCHED; PG8_LDA(At, 0, 0); PG8_STAGE(PG8_SA(1, 1), a1 + hstepA, voffA);
            PG8_WAIT_L(8); PG8_BAR; PG8_WAIT_L(0); PG8_MMA(0, 0, At, B0); PG8_BAR; PG8_SCHED;
            PG8_LDB(B1, 0, 1); PG8_STAGE(PG8_SB(0, 0), b2, voffB);
            PG8_BAR; PG8_WAIT_L(0); PG8_MMA(0, 1, At, B1); PG8_BAR;
            PG8_LDA(At, 0, 1); PG8_STAGE(PG8_SA(0, 0), a2, voffA);
            PG8_BAR; PG8_WAIT_L(0); PG8_MMA(1, 0, At, B0); PG8_BAR; PG8_SCHED;
            PG8_STAGE(PG8_SB(0, 1), b2 + hstepB, voffB);
            PG8_WAIT_V(6); PG8_BAR; PG8_MMA(1, 1, At, B1); PG8_BAR;
            PG8_LDB(B0, 1, 0); PG8_SCHED; PG8_LDA(At, 1, 0); PG8_STAGE(PG8_SA(0, 1), a2 + hstepA, voffA);
            PG8_WAIT_L(8); PG8_BAR; PG8_WAIT_L(0); PG8_MMA(0, 0, At, B0); PG8_BAR; PG8_SCHED;
            PG8_LDB(B1, 1, 1); PG8_STAGE(PG8_SB(1, 0), b3, voffB);
            PG8_BAR; PG8_WAIT_L(0); PG8_MMA(0, 1, At, B1); PG8_BAR;
            PG8_LDA(At, 1, 1); PG8_STAGE(PG8_SA(1, 0), a3, voffA);
            PG8_BAR; PG8_WAIT_L(0); PG8_MMA(1, 0, At, B0); PG8_BAR; PG8_SCHED;
            PG8_STAGE(PG8_SB(1, 1), b3 + hstepB, voffB);
            PG8_WAIT_V(6); PG8_BAR; PG8_MMA(1, 1, At, B1); PG8_BAR;
            }
        }
        if constexpr (ALIGN_EPI) { if (wr == 0) PG8_BAR; }
        if constexpr (!Epi::AFTER_DRAIN) { E(acc, cur, wr, wc, fr, fq); S.done(cur); }
        if (!has_next) break;
#pragma unroll
        for (int a = 0; a < 2; ++a)
#pragma unroll
            for (int b = 0; b < 2; ++b)
#pragma unroll
                for (int m = 0; m < 4; ++m)
#pragma unroll
                    for (int n = 0; n < 2; ++n) acc[a][b][m][n] = (f32x4){0.f, 0.f, 0.f, 0.f};
        cur = nxt; cA = nA; cB = nB; ++ui;
        if constexpr (ALIGN_EPI) { if (wr == 1) PG8_BAR; }
    }
    PG8_WAIT_V(0);
    if constexpr (!ALIGN_EPI) { if (wr == 0) PG8_BAR; }
    PG8_BAR;
    if constexpr (Epi::AFTER_DRAIN) { E.fused(acc, cur, wr, wc, fr, fq, lds, wid, lane); S.done(cur); }
#undef PG8_SA
#undef PG8_SB
#undef PG8_STAGE
#undef PG8_LDA
#undef PG8_LDB
#undef PG8_MMA
#undef PG8_WAIT_V
#undef PG8_WAIT_L
#undef PG8_BAR
#undef PG8_SCHED
}
}
using pg8::Unit;
#define LAS __attribute__((address_space(3)))
#define LDS_WAIT() asm volatile("s_waitcnt lgkmcnt(0)" ::: "memory")

constexpr int NBATCH = 8, SEQ = 4096, T = NBATCH * SEQ, DM = 1024, DFF = 4096;
constexpr int NA = 2816, NG = 3072;
constexpr int LDSM = 768;
constexpr float EPS = 1e-6f, LOG2E = 1.4426950408889634f;
constexpr float QSCALE = 0.10206207261596575f * LOG2E;
constexpr float GLA_QSCALE = 0.08838834764831845f;
constexpr int NWAVES = 8, NTHR = 512;
constexpr int LDS_BYTES = 147456, LDS_MISC = 131072;

constexpr size_t MiB = 1u << 20;
constexpr size_t WS_WINA = 0, WS_WINB = 6 * MiB, WS_WUQ = 12 * MiB, WS_WUKV = 13 * MiB, WS_WOUT = 14 * MiB, WS_W1 = 16 * MiB, WS_W2 = 24 * MiB;
constexpr size_t WS_ROPEC = 33 * MiB, WS_ROPES = 35 * MiB, WS_SSQ = 37 * MiB, WS_CTL = 37 * MiB + 512 * 1024;
constexpr size_t WS_XN = 38 * MiB, WS_MERGED = 38 * MiB;
constexpr size_t WS_GQKV = 102 * MiB, WS_K = 230 * MiB, WS_V = 278 * MiB, WS_GATES = 102 * MiB, WS_U = 102 * MiB;
constexpr size_t WS_QO = 342 * MiB, WS_SMALL = 406 * MiB, WS_OB = 406 * MiB, WS_HB = 406 * MiB, WS_END = 470 * MiB;
constexpr int LDU = DFF + 64;

struct Args { const float* x; const int* pos; const float *g_mix, *w_in, *w_gate_f, *b_gate_f, *w_gate_b, *b_gate_b, *g_gla, *g_q, *w_uq, *g_kv, *w_ukv, *w_out, *g_mlp, *w_ff1, *w_ff2, *g_final;
              float* out; unsigned char* ws; int ph_lo, ph_hi; };

DI float wave_sum(float v) {
#pragma unroll
    for (int o = 1; o < 64; o <<= 1) v += __shfl_xor(v, o);
    return v;
}
DI float sigmoidf_(float x) { return __builtin_amdgcn_rcpf(1.0f + __builtin_amdgcn_exp2f(-LOG2E * x)); }
DI float logsig2_(float x) { return fminf(x, 0.f) * LOG2E - __builtin_amdgcn_logf(1.0f + __builtin_amdgcn_exp2f(-LOG2E * fabsf(x))); }

struct EpiP1a {
    static constexpr bool PERM = true, AFTER_DRAIN = false;
    bf16_t* gqkv; bf16_t* small; float* ssq_q; float* ssq_kv;
    DI void operator()(const f32x4 (&acc)[2][2][4][2], const Unit& u, int wr, int wc, int fr, int fq) const {
        const int row0 = u.pm * 256 + wr * 64 + fr;
#pragma unroll
        for (int bj = 0; bj < 2; ++bj) {
            const int gc = u.pn * 256 + bj * 128 + wc * 32;
            bf16_t* base; int ld, c; float* ssq = nullptr;
            if (gc < 2048) { base = gqkv; ld = 2048; c = gc; }
            else { base = small; ld = LDSM; c = gc - 2048; if (c >= 32 && c < 416) ssq = ssq_q; else if (c >= 416 && c < 672) ssq = ssq_kv; }
#pragma unroll
            for (int ai = 0; ai < 2; ++ai)
#pragma unroll
                for (int m = 0; m < 4; ++m) {
                    const int row = row0 + ai * 128 + m * 16;
                    const f32x4 v0 = acc[ai][bj][m][0], v1 = acc[ai][bj][m][1];
                    *(u32x4*)(base + (size_t)row * ld + c + 8 * fq) = pack8(v0, v1);
                    if (ssq) {
                        float s = (v0[0] * v0[0] + v0[1] * v0[1]) + (v0[2] * v0[2] + v0[3] * v0[3]) + (v1[0] * v1[0] + v1[1] * v1[1]) + (v1[2] * v1[2] + v1[3] * v1[3]);
                        s += __shfl_xor(s, 16); s += __shfl_xor(s, 32);
                        if (fq == 0) atomicAdd(ssq + row, s);
                    }
                }
        }
    }
};
struct EpiGates {
    static constexpr bool PERM = true, AFTER_DRAIN = false;
    bf16_t* gates;
    DI void operator()(const f32x4 (&acc)[2][2][4][2], const Unit& u, int wr, int wc, int fr, int fq) const {
        const int row0 = u.pm * 256 + wr * 64 + fr;
#pragma unroll
        for (int bj = 0; bj < 2; ++bj) {
            const int gc = u.pn * 256 + bj * 128 + wc * 32; const bool is_silu = gc < 1024;
#pragma unroll
            for (int ai = 0; ai < 2; ++ai)
#pragma unroll
                for (int m = 0; m < 4; ++m) {
                    const int row = row0 + ai * 128 + m * 16;
                    f32x4 v0 = acc[ai][bj][m][0], v1 = acc[ai][bj][m][1];
#pragma unroll
                    for (int e = 0; e < 4; ++e) { const float s0 = sigmoidf_(v0[e]), s1 = sigmoidf_(v1[e]); v0[e] = is_silu ? v0[e] * s0 : s0; v1[e] = is_silu ? v1[e] * s1 : s1; }
                    *(u32x4*)(gates + (size_t)row * NG + gc + 8 * fq) = pack8(v0, v1);
                }
        }
    }
};
struct EpiQ {
    static constexpr bool PERM = true, AFTER_DRAIN = false;
    bf16_t* qo; const float* ssq; const float* rc; const float* rsn;
    DI void operator()(const f32x4 (&acc)[2][2][4][2], const Unit& u, int wr, int wc, int fr, int fq) const {
        const int row0 = u.pm * 256 + wr * 64 + fr;
#pragma unroll
        for (int bj = 0; bj < 2; ++bj) {
            const int gc = u.pn * 256 + bj * 128 + wc * 32; const int h = gc / 96, j0 = gc - h * 96; const bool rope = (j0 == 64);
            const int dcol = h * 128 + j0 + 8 * fq;
#pragma unroll
            for (int ai = 0; ai < 2; ++ai)
#pragma unroll
                for (int m = 0; m < 4; ++m) {
                    const int row = row0 + ai * 128 + m * 16;
                    const float rs = rsqrtf(ssq[row] * (1.0f / 384.0f) + EPS);
                    f32x4 v0 = acc[ai][bj][m][0] * rs, v1 = acc[ai][bj][m][1] * rs;
                    if (rope) {
                        const int i0 = 8 * (fq & 1);
                        const f32x4 c0 = *(const f32x4*)(rc + (size_t)row * 16 + i0), c1 = *(const f32x4*)(rc + (size_t)row * 16 + i0 + 4);
                        const f32x4 s0 = *(const f32x4*)(rsn + (size_t)row * 16 + i0), s1 = *(const f32x4*)(rsn + (size_t)row * 16 + i0 + 4);
                        const float sg = (fq < 2) ? -1.0f : 1.0f;
                        f32x4 p0, p1;
#pragma unroll
                        for (int e = 0; e < 4; ++e) { p0[e] = __shfl_xor(v0[e], 32); p1[e] = __shfl_xor(v1[e], 32); }
                        v0 = v0 * c0 + (p0 * s0) * sg; v1 = v1 * c1 + (p1 * s1) * sg;
                    }
                    v0 = v0 * QSCALE; v1 = v1 * QSCALE;
                    *(u32x4*)(qo + (size_t)row * 1024 + dcol) = pack8(v0, v1);
                    asm volatile("" ::: "memory");
                }
        }
    }
};
struct EpiKV {
    static constexpr bool PERM = true, AFTER_DRAIN = false;
    bf16_t* kb; bf16_t* vb; const float* ssq;
    DI void operator()(const f32x4 (&acc)[2][2][4][2], const Unit& u, int wr, int wc, int fr, int fq) const {
        const int row0 = u.pm * 256 + wr * 64 + fr;
#pragma unroll
        for (int bj = 0; bj < 2; ++bj) {
            const int gc = u.pn * 256 + bj * 128 + wc * 32; const int h = gc / 192, j0 = gc - h * 192;
            bf16_t* base; int ld, c;
            if (j0 < 64) { base = kb; ld = 768; c = h * 96 + j0 + 8 * fq; } else { base = vb; ld = 1024; c = h * 128 + (j0 - 64) + 8 * fq; }
#pragma unroll
            for (int ai = 0; ai < 2; ++ai)
#pragma unroll
                for (int m = 0; m < 4; ++m) {
                    const int row = row0 + ai * 128 + m * 16;
                    const float rs = rsqrtf(ssq[row] * (1.0f / 256.0f) + EPS);
                    *(u32x4*)(base + (size_t)row * ld + c) = pack8(acc[ai][bj][m][0] * rs, acc[ai][bj][m][1] * rs);
                }
        }
    }
};
template <bool WRITE_HB> struct EpiRes {
    static constexpr bool PERM = true, AFTER_DRAIN = false;
    const float* base; float* out; bf16_t* hb; float* ssq;
    DI void operator()(const f32x4 (&acc)[2][2][4][2], const Unit& u, int wr, int wc, int fr, int fq) const {
        const int row0 = u.pm * 256 + wr * 64 + fr; const int colb = u.pn * 256 + wc * 32 + 8 * fq;
#pragma unroll
        for (int ai = 0; ai < 2; ++ai) {
            f32x4 pre[4][2][2];
#pragma unroll
            for (int m = 0; m < 4; ++m)
#pragma unroll
                for (int bj = 0; bj < 2; ++bj) { const size_t off = (size_t)(row0 + ai * 128 + m * 16) * DM + colb + bj * 128;
                    pre[m][bj][0] = *(const f32x4*)(base + off); pre[m][bj][1] = *(const f32x4*)(base + off + 4); }
            asm volatile("" ::: "memory");
#pragma unroll
            for (int m = 0; m < 4; ++m) {
                const int row = row0 + ai * 128 + m * 16; float s = 0.f;
#pragma unroll
                for (int bj = 0; bj < 2; ++bj) {
                    const size_t off = (size_t)row * DM + colb + bj * 128;
                    const f32x4 v0 = pre[m][bj][0] + acc[ai][bj][m][0], v1 = pre[m][bj][1] + acc[ai][bj][m][1];
                    *(f32x4*)(out + off) = v0; *(f32x4*)(out + off + 4) = v1;
                    if (WRITE_HB) *(u32x4*)(hb + off) = pack8(v0, v1);
                    s += (v0[0] * v0[0] + v0[1] * v0[1]) + (v0[2] * v0[2] + v0[3] * v0[3]) + (v1[0] * v1[0] + v1[1] * v1[1]) + (v1[2] * v1[2] + v1[3] * v1[3]);
                }
                s += __shfl_xor(s, 16); s += __shfl_xor(s, 32);
                if (fq == 0) atomicAdd(ssq + row, s);
            }
            asm volatile("" ::: "memory");
        }
    }
};
template <bool BASE_BF16> struct EpiResB {
    static constexpr bool PERM = true, AFTER_DRAIN = false;
    const void* base; bf16_t* hb; float* ssq;
    DI void operator()(const f32x4 (&acc)[2][2][4][2], const Unit& u, int wr, int wc, int fr, int fq) const {
        const int row0 = u.pm * 256 + wr * 64 + fr; const int colb = u.pn * 256 + wc * 32 + 8 * fq;
#pragma unroll
        for (int ai = 0; ai < 2; ++ai) {
            f32x4 pre[4][2][2];
#pragma unroll
            for (int m = 0; m < 4; ++m)
#pragma unroll
                for (int bj = 0; bj < 2; ++bj) { const size_t off = (size_t)(row0 + ai * 128 + m * 16) * DM + colb + bj * 128;
                    if (BASE_BF16) { float f[8]; unpack8(__builtin_nontemporal_load((const u32x4*)((const bf16_t*)base + off)), f); pre[m][bj][0] = (f32x4){f[0], f[1], f[2], f[3]}; pre[m][bj][1] = (f32x4){f[4], f[5], f[6], f[7]}; }
                    else { pre[m][bj][0] = __builtin_nontemporal_load((const f32x4*)((const float*)base + off)); pre[m][bj][1] = __builtin_nontemporal_load((const f32x4*)((const float*)base + off + 4)); } }
            asm volatile("" ::: "memory");
#pragma unroll
            for (int m = 0; m < 4; ++m) {
                const int row = row0 + ai * 128 + m * 16; float s = 0.f;
#pragma unroll
                for (int bj = 0; bj < 2; ++bj) {
                    const size_t off = (size_t)row * DM + colb + bj * 128;
                    const f32x4 v0 = pre[m][bj][0] + acc[ai][bj][m][0], v1 = pre[m][bj][1] + acc[ai][bj][m][1];
                    *(u32x4*)(hb + off) = pack8(v0, v1);
                    s += (v0[0] * v0[0] + v0[1] * v0[1]) + (v0[2] * v0[2] + v0[3] * v0[3]) + (v1[0] * v1[0] + v1[1] * v1[1]) + (v1[2] * v1[2] + v1[3] * v1[3]);
                }
                if (ssq) { s += __shfl_xor(s, 16); s += __shfl_xor(s, 32);
                    if (fq == 0) atomicAdd(ssq + row, s); }
            }
            asm volatile("" ::: "memory");
        }
    }
};
struct EpiFF1 {
    static constexpr bool PERM = true, AFTER_DRAIN = false;
    bf16_t* ub; const float* ssq;
    DI void operator()(const f32x4 (&acc)[2][2][4][2], const Unit& u, int wr, int wc, int fr, int fq) const {
        const int row0 = u.pm * 256 + wr * 64 + fr;
#pragma unroll
        for (int ai = 0; ai < 2; ++ai)
#pragma unroll
            for (int m = 0; m < 4; ++m) {
                const int row = row0 + ai * 128 + m * 16;
                const float rs = rsqrtf(ssq[row] * (1.0f / 1024.0f) + EPS);
#pragma unroll
                for (int bj = 0; bj < 2; ++bj) {
                    f32x4 v0 = acc[ai][bj][m][0] * rs, v1 = acc[ai][bj][m][1] * rs;
#pragma unroll
                    for (int e = 0; e < 4; ++e) { const float a = fmaxf(v0[e], 0.f), b = fmaxf(v1[e], 0.f); v0[e] = a * a; v1[e] = b * b; }
                    { const int col = u.pn * 256 + bj * 128 + wc * 32 + 8 * fq;
                      *(u32x4*)(ub + (((size_t)(row >> 8) * (DFF / 64) + (col >> 6)) * 256 + (row & 255)) * 64 + (col & 63)) = pack8(v0, v1); }
                }
            }
    }
};

namespace att {
constexpr int QBLK = 32, KVBLK = 64, LDQ = 1024, LDKK = 768, LDKV = 1024;
#ifndef ATT_SDEPTH
#define ATT_SDEPTH 1
#endif
constexpr int SDEPTH = ATT_SDEPTH;
constexpr float THRL = 11.5f;
constexpr size_t SHM_V = KVBLK * 128 * 2, SHM_K = KVBLK * 256, SHM_ATTN = 2 * SHM_V + 2 * SHM_K + NWAVES * 64 * 4;
#define KSWZ(row, colB) ((row) * 256 + ((colB) ^ (((row) & 15) << 4)))
#define SBAR() __builtin_amdgcn_sched_barrier(0)
DI int crow(int r, int hi) { return (r & 3) + 8 * (r >> 2) + 4 * hi; }
DI void partialSM(f32x16& p0, f32x16& p1, float& m_reg, float& mn, float& alpha) {
  float pmax = p0[0];
#pragma unroll
  for (int r = 1; r < 16; ++r) pmax = fmaxf(pmax, p0[r]);
#pragma unroll
  for (int r = 0; r < 16; ++r) pmax = fmaxf(pmax, p1[r]);
  { auto rr = __builtin_amdgcn_permlane32_swap(__float_as_uint(pmax), __float_as_uint(pmax), false, false);
    pmax = fmaxf(__uint_as_float(rr[0]), __uint_as_float(rr[1])); }
  if (__builtin_expect(__all(pmax - m_reg <= THRL), 1)) { mn = m_reg; alpha = 1.f; }
  else { mn = fmaxf(m_reg, pmax); alpha = __builtin_amdgcn_exp2f(m_reg - mn); m_reg = mn; }
#pragma unroll
  for (int r = 0; r < 16; ++r) p0[r] = p0[r] - mn;
#pragma unroll
  for (int r = 0; r < 16; ++r) p1[r] = p1[r] - mn;
#pragma unroll
  for (int r = 0; r < 16; ++r) p0[r] = __builtin_amdgcn_exp2f(p0[r]);
}
DI void finishSM(f32x16& p0, f32x16& p1, float alpha, float& l_reg, bf16x8& pa0, bf16x8& pa1, bf16x8& pa2, bf16x8& pa3) {
#pragma unroll
  for (int r = 0; r < 16; ++r) p1[r] = __builtin_amdgcn_exp2f(p1[r]);
  float ps = 0;
#pragma unroll
  for (int r = 0; r < 16; ++r) ps += p0[r];
#pragma unroll
  for (int r = 0; r < 16; ++r) ps += p1[r];
  { auto rr = __builtin_amdgcn_permlane32_swap(__float_as_uint(ps), __float_as_uint(ps), false, false);
    ps = __uint_as_float(rr[0]) + __uint_as_float(rr[1]); }
  l_reg = l_reg * alpha + ps;
#define PK4(P, BASE, OUT) do { unsigned a0 = cvt_pk_bf16(P[BASE + 0], P[BASE + 1]), a1 = cvt_pk_bf16(P[BASE + 2], P[BASE + 3]);   \
    unsigned b0 = cvt_pk_bf16(P[BASE + 4], P[BASE + 5]), b1 = cvt_pk_bf16(P[BASE + 6], P[BASE + 7]);                              \
    auto r0 = __builtin_amdgcn_permlane32_swap(a0, b0, false, false); auto r1 = __builtin_amdgcn_permlane32_swap(a1, b1, false, false); \
    u32x4 w = {r0[0], r1[0], r0[1], r1[1]}; OUT = *reinterpret_cast<bf16x8*>(&w); } while (0)
  PK4(p0, 0, pa0); PK4(p0, 8, pa1); PK4(p1, 0, pa2); PK4(p1, 8, pa3);
#undef PK4
}
DI void qkt(f32x16& p0, f32x16& p1, const bf16_t* Ks, const bf16x8* qr, int r32, int hi) {
  p0 = f32x16{}; p1 = f32x16{};
#pragma unroll
  for (int d0 = 0; d0 < 6; ++d0) { const int cb = (d0 * 16 + hi * 8) * 2;
    bf16x8 b0 = *reinterpret_cast<const bf16x8*>((const char*)Ks + KSWZ(r32, cb));
    bf16x8 b1 = *reinterpret_cast<const bf16x8*>((const char*)Ks + KSWZ(32 + r32, cb));
    p0 = __builtin_amdgcn_mfma_f32_32x32x16_bf16(b0, qr[d0], p0, 0, 0, 0);
    p1 = __builtin_amdgcn_mfma_f32_32x32x16_bf16(b1, qr[d0], p1, 0, 0, 0); }
}
DI int v_st(int k, int c) { const int kk = (k & ~0xC) | ((k & 4) << 1) | ((k & 8) >> 1); return ((kk >> 3) * 4 + (c >> 5)) * 512 + ((kk & 7) * 32 + (c & 31)) * 2; }
DI int v_rd_base(int lane) { return ((lane & 3) << 3) | (((lane >> 2) & 3) << 6) | (((lane >> 4) & 1) << 5) | (((lane >> 5) & 1) << 8); }
constexpr int v_rd_off(int d0, int ks, int half) { return d0 * 512 + ks * 4096 + half * 2048; }
template <int OFF> DI s16x4 tr_read(int vb) {
  s16x4 r; asm volatile("ds_read_b64_tr_b16 %0, %1 offset:%2" : "=&v"(r) : "v"(vb), "i"(OFF) : "memory"); return r;
}
template <int D0> DI void pv_one(f32x16& od, int vb, bf16x8 pa0, bf16x8 pa1, bf16x8 pa2, bf16x8 pa3) {
  const s16x4 l0 = tr_read<v_rd_off(D0, 0, 0)>(vb), h0 = tr_read<v_rd_off(D0, 0, 1)>(vb), l1 = tr_read<v_rd_off(D0, 1, 0)>(vb), h1 = tr_read<v_rd_off(D0, 1, 1)>(vb);
  const s16x4 l2 = tr_read<v_rd_off(D0, 2, 0)>(vb), h2 = tr_read<v_rd_off(D0, 2, 1)>(vb), l3 = tr_read<v_rd_off(D0, 3, 0)>(vb), h3 = tr_read<v_rd_off(D0, 3, 1)>(vb);
  asm volatile("s_waitcnt lgkmcnt(0)" ::: "memory"); SBAR();
#define PK(L, H) (bf16x8){L[0], L[1], L[2], L[3], H[0], H[1], H[2], H[3]}
  od = __builtin_amdgcn_mfma_f32_32x32x16_bf16(pa0, PK(l0, h0), od, 0, 0, 0);
  od = __builtin_amdgcn_mfma_f32_32x32x16_bf16(pa1, PK(l1, h1), od, 0, 0, 0);
  od = __builtin_amdgcn_mfma_f32_32x32x16_bf16(pa2, PK(l2, h2), od, 0, 0, 0);
  od = __builtin_amdgcn_mfma_f32_32x32x16_bf16(pa3, PK(l3, h3), od, 0, 0, 0);
#undef PK
}
DI void pv_d0(f32x16* o, int vb, bf16x8 pa0, bf16x8 pa1, bf16x8 pa2, bf16x8 pa3) {
  pv_one<0>(o[0], vb, pa0, pa1, pa2, pa3); pv_one<1>(o[1], vb, pa0, pa1, pa2, pa3); pv_one<2>(o[2], vb, pa0, pa1, pa2, pa3); pv_one<3>(o[3], vb, pa0, pa1, pa2, pa3);
}
DI void attn_dense_body(const bf16_t* Qb, const bf16_t* __restrict__ Kh, const bf16_t* __restrict__ Vh, bf16_t* Ob, int seq, char* lds) {
  const int tid = threadIdx.x, wid = tid >> 6, lane = tid & 63, r32 = lane & 31, hi = lane >> 5;
  bf16_t* V_lds = (bf16_t*)lds; bf16_t* K_lds = (bf16_t*)(lds + 2 * SHM_V);
  float* ws = (float*)(lds + 2 * SHM_V + 2 * SHM_K) + wid * 64; float* li_l = ws; float* al_l = ws + 32;
  float m_reg = -1e30f, l_reg = 0; f32x16 o[4] = {}; bf16x8 qr[6];
  const bf16_t* Qw = Qb + (long)(wid * QBLK + r32) * LDQ + hi * 8;
#pragma unroll
  for (int d0 = 0; d0 < 6; ++d0) qr[d0] = __builtin_nontemporal_load(reinterpret_cast<const bf16x8*>(Qw + d0 * 16));
  const int sr = tid >> 4, sc = (tid & 15) * 8, vst0 = v_st(sr, sc), vst1 = v_st(32 + sr, sc);
  const int kr0 = tid / 12, kc0 = (tid - kr0 * 12) * 8, kr1 = (tid + 512) / 12, kc1 = ((tid + 512) - kr1 * 12) * 8;
  const bool k2 = wid < 4;
  const int kst0 = KSWZ(kr0, kc0 * 2), kst1 = KSWZ(kr1, kc1 * 2);
  const int vb0 = (int)(uintptr_t)V_lds + v_rd_base(lane);
  struct { bf16x8 vs0, vs1, ks0, ks1; } sr_[SDEPTH];
#define SLOAD(i, k0) do { sr_[i].vs0 = *(const bf16x8*)(&Vh[(long)((k0) + sr) * LDKV + sc]); sr_[i].vs1 = *(const bf16x8*)(&Vh[(long)((k0) + 32 + sr) * LDKV + sc]); \
    sr_[i].ks0 = *(const bf16x8*)(&Kh[(long)((k0) + kr0) * LDKK + kc0]); if (k2) sr_[i].ks1 = *(const bf16x8*)(&Kh[(long)((k0) + kr1) * LDKK + kc1]); } while (0)
#define SWRITE(b, i) do { *(bf16x8*)((char*)V_lds + (b) * SHM_V + vst0) = sr_[i].vs0; *(bf16x8*)((char*)V_lds + (b) * SHM_V + vst1) = sr_[i].vs1; \
    *(bf16x8*)((char*)K_lds + (b) * SHM_K + kst0) = sr_[i].ks0; if (k2) *(bf16x8*)((char*)K_lds + (b) * SHM_K + kst1) = sr_[i].ks1; } while (0)
#define SWAIT() do { if (SDEPTH == 2) asm volatile("s_waitcnt vmcnt(4)" ::: "memory"); else asm volatile("s_waitcnt vmcnt(0)" ::: "memory"); } while (0)
#define RESC(a) do { if (__any((a) < 1.f)) { if (hi == 0) al_l[r32] = (a); asm volatile("s_waitcnt lgkmcnt(0)" ::: "memory"); \
    _Pragma("unroll") for (int d = 0; d < 4; ++d) _Pragma("unroll") for (int r = 0; r < 16; ++r) o[d][r] *= al_l[crow(r, hi)]; } } while (0)
  f32x16 pA0, pA1, pB0, pB1; float mnA, mnB, alA, alB; bf16x8 pa0, pa1, pa2, pa3; const int NT = seq / KVBLK;
  constexpr int SE = 0, SO = SDEPTH - 1;
  SLOAD(SE, 0); asm volatile("s_waitcnt vmcnt(0)" ::: "memory"); SWRITE(0, SE); __syncthreads();
  qkt(pA0, pA1, K_lds, qr, r32, hi); partialSM(pA0, pA1, m_reg, mnA, alA);
  SLOAD(SO, KVBLK); if (SDEPTH == 2) { if (2 < NT) SLOAD(SE, 2 * KVBLK); }
  SWAIT(); SWRITE(1, SO); __syncthreads();
  for (int j = 1; j + 1 < NT; j += 2) {
    SBAR(); qkt(pB0, pB1, (bf16_t*)((char*)K_lds + SHM_K), qr, r32, hi);
    finishSM(pA0, pA1, alA, l_reg, pa0, pa1, pa2, pa3); SBAR();
    SLOAD(SO, (j + SDEPTH) * KVBLK); SBAR();
    pv_d0(o, vb0, pa0, pa1, pa2, pa3); partialSM(pB0, pB1, m_reg, mnB, alB);
    __syncthreads(); SWAIT(); SWRITE(0, SE);
    RESC(alB); __syncthreads();
    SBAR(); qkt(pA0, pA1, K_lds, qr, r32, hi);
    finishSM(pB0, pB1, alB, l_reg, pa0, pa1, pa2, pa3); SBAR();
    if (SDEPTH == 1 || j + 3 < NT) SLOAD(SE, (j + 1 + SDEPTH) * KVBLK); SBAR();
    pv_d0(o, vb0 + (int)SHM_V, pa0, pa1, pa2, pa3); partialSM(pA0, pA1, m_reg, mnA, alA);
    __syncthreads(); SWAIT(); SWRITE(1, SO);
    RESC(alA); __syncthreads();
  }
  SBAR(); qkt(pB0, pB1, (bf16_t*)((char*)K_lds + SHM_K), qr, r32, hi);
  finishSM(pA0, pA1, alA, l_reg, pa0, pa1, pa2, pa3); SBAR();
  pv_d0(o, vb0, pa0, pa1, pa2, pa3); partialSM(pB0, pB1, m_reg, mnB, alB);
  __syncthreads(); RESC(alB);
  finishSM(pB0, pB1, alB, l_reg, pa0, pa1, pa2, pa3); SBAR();
  pv_d0(o, vb0 + (int)SHM_V, pa0, pa1, pa2, pa3);
  if (hi == 0) li_l[r32] = l_reg; asm volatile("s_waitcnt lgkmcnt(0)" ::: "memory");
  float rli[16];
#pragma unroll
  for (int r = 0; r < 16; ++r) rli[r] = __builtin_amdgcn_rcpf(li_l[crow(r, hi)]);
  bf16_t* Ow = Ob + (long)(wid * QBLK) * LDQ;
#pragma unroll
  for (int r = 0; r < 16; ++r) { const int orow = crow(r, hi);
#pragma unroll
    for (int d0 = 0; d0 < 4; ++d0) __builtin_nontemporal_store((bf16_t)(cvt_pk_bf16(o[d0][r] * rli[r], 0.f) & 0xffffu), Ow + (long)orow * LDQ + d0 * 32 + r32); }
  __syncthreads();
#undef SLOAD
#undef SWRITE
#undef SWAIT
#undef RESC
}
}

namespace gla {
constexpr int QD_OFF = 0, KD_OFF = 17408, KE_OFF = 34816, VV_OFF = 51200, PP_OFF = 83968, DD_OFF = 93184, QROW = 272, PROW = 144;
#define GLA_BAR() do { asm volatile("s_waitcnt lgkmcnt(0)" ::: "memory"); __builtin_amdgcn_s_barrier(); asm volatile("" ::: "memory"); } while (0)
#define MFMA32(a, b, c) __builtin_amdgcn_mfma_f32_32x32x16_bf16((a), (b), (c), 0, 0, 0)
DI bf16x8 pack_step(const f32x16& x, int s) {
    u32x4 p; p.x = cvt_pk_bf16(x[8 * s], x[8 * s + 1]); p.y = cvt_pk_bf16(x[8 * s + 2], x[8 * s + 3]); p.z = cvt_pk_bf16(x[8 * s + 4], x[8 * s + 5]); p.w = cvt_pk_bf16(x[8 * s + 6], x[8 * s + 7]);
    return __builtin_bit_cast(bf16x8, p);
}
template <int DIR> DI void unit(int b, int h, const bf16_t* __restrict__ gqkv, const _Float16* __restrict__ bc, bf16_t* __restrict__ oo, char* lds) {
    using att::v_st; using att::v_rd_base; using att::v_rd_off; using att::tr_read; using att::crow;
    const int tid = threadIdx.x, lane = tid & 63, wid = tid >> 6, r32 = lane & 31, hi = lane >> 5, fr = lane & 15, fq = lane >> 4;
    const int t = tid >> 3, g = tid & 7, sr = tid >> 4, sc = (tid & 15) * 8;
    char* QD = lds + QD_OFF; char* KD = lds + KD_OFF; char* KE = lds + KE_OFF; char* VV = lds + VV_OFF; char* PP = lds + PP_OFF; float* DD = (float*)(lds + DD_OFF);
    const int vst0 = v_st(sr, sc), vst1 = v_st(32 + sr, sc), kst0 = v_st(t, 16 * g), kst1 = v_st(t, 16 * g + 8);
    const int vb = (int)(uintptr_t)VV + (wid >> 2) * 16384 + (wid & 3) * 512 + v_rd_base(lane), keb = (int)(uintptr_t)KE + v_rd_base(lane);
    f32x16 st[4] = {};
    u32x4 q0, q1, k0, k1; f16x8 b0, b1, l0, l1; bf16x8 vs0, vs1, vs2, vs3;
#define GLOAD(ci_) do { const int chunk_ = DIR ? 63 - (ci_) : (ci_); const long row0_ = (long)b * SEQ + chunk_ * 64; \
        const bf16_t* qp_ = gqkv + (row0_ + t) * 2048 + h * 128 + g * 16; q0 = __builtin_nontemporal_load((const u32x4*)qp_); q1 = __builtin_nontemporal_load((const u32x4*)(qp_ + 8)); k0 = __builtin_nontemporal_load((const u32x4*)(qp_ + 512)); k1 = __builtin_nontemporal_load((const u32x4*)(qp_ + 520)); \
        const _Float16* bp_ = bc + (row0_ + t) * 512 + h * 128 + g * 16; b0 = __builtin_nontemporal_load((const f16x8*)bp_); b1 = __builtin_nontemporal_load((const f16x8*)(bp_ + 8)); \
        const _Float16* lp_ = bc + (row0_ + (DIR ? 0 : 63)) * 512 + h * 128 + g * 16; l0 = *(const f16x8*)lp_; l1 = *(const f16x8*)(lp_ + 8); \
        const bf16_t* vp_ = gqkv + (row0_ + sr) * 2048 + 1024 + h * 256 + sc; vs0 = __builtin_nontemporal_load((const bf16x8*)vp_); vs1 = __builtin_nontemporal_load((const bf16x8*)(vp_ + 128)); vs2 = __builtin_nontemporal_load((const bf16x8*)(vp_ + 32 * 2048)); vs3 = __builtin_nontemporal_load((const bf16x8*)(vp_ + 32 * 2048 + 128)); } while (0)
    GLOAD(0);
    for (int ci = 0; ci < 64; ++ci) {
        const int chunk = DIR ? 63 - ci : ci; const long row0 = (long)b * SEQ + chunk * 64;
        { float qf[16], kf[16]; unpack8(q0, qf); unpack8(q1, qf + 8); unpack8(k0, kf); unpack8(k1, kf + 8);
          float qd[16], kd[16], ke[16], dl[16];
#pragma unroll
          for (int j = 0; j < 16; ++j) { const float bb = (float)(j < 8 ? b0[j & 7] : b1[j & 7]), ll = (float)(j < 8 ? l0[j & 7] : l1[j & 7]);
              qd[j] = qf[j] * GLA_QSCALE * __builtin_amdgcn_exp2f(bb); kd[j] = kf[j] * __builtin_amdgcn_exp2f(-bb); ke[j] = kf[j] * __builtin_amdgcn_exp2f(ll - bb); dl[j] = __builtin_amdgcn_exp2f(ll); }
          u32x4 w;
          w.x = cvt_pk_bf16(qd[0], qd[1]); w.y = cvt_pk_bf16(qd[2], qd[3]); w.z = cvt_pk_bf16(qd[4], qd[5]); w.w = cvt_pk_bf16(qd[6], qd[7]); *(u32x4*)(QD + t * QROW + g * 32) = w;
          w.x = cvt_pk_bf16(qd[8], qd[9]); w.y = cvt_pk_bf16(qd[10], qd[11]); w.z = cvt_pk_bf16(qd[12], qd[13]); w.w = cvt_pk_bf16(qd[14], qd[15]); *(u32x4*)(QD + t * QROW + g * 32 + 16) = w;
          w.x = cvt_pk_bf16(kd[0], kd[1]); w.y = cvt_pk_bf16(kd[2], kd[3]); w.z = cvt_pk_bf16(kd[4], kd[5]); w.w = cvt_pk_bf16(kd[6], kd[7]); *(u32x4*)(KD + t * QROW + g * 32) = w;
          w.x = cvt_pk_bf16(kd[8], kd[9]); w.y = cvt_pk_bf16(kd[10], kd[11]); w.z = cvt_pk_bf16(kd[12], kd[13]); w.w = cvt_pk_bf16(kd[14], kd[15]); *(u32x4*)(KD + t * QROW + g * 32 + 16) = w;
          w.x = cvt_pk_bf16(ke[0], ke[1]); w.y = cvt_pk_bf16(ke[2], ke[3]); w.z = cvt_pk_bf16(ke[4], ke[5]); w.w = cvt_pk_bf16(ke[6], ke[7]); *(u32x4*)(KE + kst0) = w;
          w.x = cvt_pk_bf16(ke[8], ke[9]); w.y = cvt_pk_bf16(ke[10], ke[11]); w.z = cvt_pk_bf16(ke[12], ke[13]); w.w = cvt_pk_bf16(ke[14], ke[15]); *(u32x4*)(KE + kst1) = w;
          if (t == (DIR ? 0 : 63)) {
#pragma unroll
              for (int j = 0; j < 16; ++j) DD[16 * g + j] = dl[j]; }
          *(bf16x8*)(VV + vst0) = vs0; *(bf16x8*)(VV + 16384 + vst0) = vs1; *(bf16x8*)(VV + vst1) = vs2; *(bf16x8*)(VV + 16384 + vst1) = vs3; }
        if (ci + 1 < 64) GLOAD(ci + 1);
        GLA_BAR();
        { const int ti = wid >> 1, jb = (wid & 1) * 2; f32x4 s0 = {0.f, 0.f, 0.f, 0.f}, s1 = s0;
#pragma unroll
          for (int ks = 0; ks < 4; ++ks) {
              const bf16x8 af = *(const bf16x8*)(QD + (16 * ti + fr) * QROW + (ks * 32 + fq * 8) * 2);
              const bf16x8 bf0 = *(const bf16x8*)(KD + (16 * jb + fr) * QROW + (ks * 32 + fq * 8) * 2), bf1 = *(const bf16x8*)(KD + (16 * jb + 16 + fr) * QROW + (ks * 32 + fq * 8) * 2);
              s0 = __builtin_amdgcn_mfma_f32_16x16x32_bf16(af, bf0, s0, 0, 0, 0); s1 = __builtin_amdgcn_mfma_f32_16x16x32_bf16(af, bf1, s1, 0, 0, 0); }
#pragma unroll
          for (int r = 0; r < 4; ++r) { const int tt = 16 * ti + 4 * fq + r, c0 = 16 * jb + fr, c1 = c0 + 16;
              const bool keep0 = DIR ? (c0 > tt) : (c0 <= tt), keep1 = DIR ? (c1 > tt) : (c1 <= tt);
              *(bf16_t*)(PP + tt * PROW + c0 * 2) = (bf16_t)(cvt_pk_bf16(keep0 ? s0[r] : 0.f, 0.f) & 0xffffu);
              *(bf16_t*)(PP + tt * PROW + c1 * 2) = (bf16_t)(cvt_pk_bf16(keep1 ? s1[r] : 0.f, 0.f) & 0xffffu); } }
        GLA_BAR();
        { bf16x8 vf[4];
          { const s16x4 a0 = tr_read<v_rd_off(0, 0, 0)>(vb), c0 = tr_read<v_rd_off(0, 0, 1)>(vb), a1 = tr_read<v_rd_off(0, 1, 0)>(vb), c1 = tr_read<v_rd_off(0, 1, 1)>(vb);
            const s16x4 a2 = tr_read<v_rd_off(0, 2, 0)>(vb), c2 = tr_read<v_rd_off(0, 2, 1)>(vb), a3 = tr_read<v_rd_off(0, 3, 0)>(vb), c3 = tr_read<v_rd_off(0, 3, 1)>(vb);
            asm volatile("s_waitcnt lgkmcnt(0)" ::: "memory"); __builtin_amdgcn_sched_barrier(0);
#define PKV(L, H) (bf16x8){L[0], L[1], L[2], L[3], H[0], H[1], H[2], H[3]}
            vf[0] = PKV(a0, c0); vf[1] = PKV(a1, c1); vf[2] = PKV(a2, c2); vf[3] = PKV(a3, c3); }
          f32x16 o0 = {}, o1 = {};
#pragma unroll
          for (int ks = 0; ks < 4; ++ks) {
              const bf16x8 pa0 = *(const bf16x8*)(PP + r32 * PROW + (16 * ks + 8 * hi) * 2), pa1 = *(const bf16x8*)(PP + (32 + r32) * PROW + (16 * ks + 8 * hi) * 2);
              o0 = MFMA32(pa0, vf[ks], o0); o1 = MFMA32(pa1, vf[ks], o1); }
#pragma unroll
          for (int ti = 0; ti < 4; ++ti)
#pragma unroll
              for (int s = 0; s < 2; ++s) {
                  const bf16x8 sb = pack_step(st[ti], s);
                  const char* qa = QD + r32 * QROW + (32 * ti + 16 * s + 4 * hi) * 2;
                  const s16x4 x0 = *(const s16x4*)qa, x1 = *(const s16x4*)(qa + 16), y0 = *(const s16x4*)(qa + 32 * QROW), y1 = *(const s16x4*)(qa + 32 * QROW + 16);
                  o0 = MFMA32(PKV(x0, x1), sb, o0); o1 = MFMA32(PKV(y0, y1), sb, o1); }
          bf16_t* op = oo + (row0) * 1024 + h * 256 + wid * 32 + r32;
#pragma unroll
          for (int r = 0; r < 16; ++r) { const int tr = crow(r, hi);
              __builtin_nontemporal_store((bf16_t)(cvt_pk_bf16(o0[r], 0.f) & 0xffffu), op + (long)tr * 1024); __builtin_nontemporal_store((bf16_t)(cvt_pk_bf16(o1[r], 0.f) & 0xffffu), op + (long)(32 + tr) * 1024); }
#define KE_TILE(TI) do { \
              const s16x4 a0 = tr_read<v_rd_off(TI, 0, 0)>(keb), c0 = tr_read<v_rd_off(TI, 0, 1)>(keb), a1 = tr_read<v_rd_off(TI, 1, 0)>(keb), c1 = tr_read<v_rd_off(TI, 1, 1)>(keb); \
              const s16x4 a2 = tr_read<v_rd_off(TI, 2, 0)>(keb), c2 = tr_read<v_rd_off(TI, 2, 1)>(keb), a3 = tr_read<v_rd_off(TI, 3, 0)>(keb), c3 = tr_read<v_rd_off(TI, 3, 1)>(keb); \
              _Pragma("unroll") for (int gq = 0; gq < 4; ++gq) { const f32x4 dv = *(const f32x4*)(DD + 32 * TI + 8 * gq + 4 * hi); \
                  st[TI][4 * gq] *= dv[0]; st[TI][4 * gq + 1] *= dv[1]; st[TI][4 * gq + 2] *= dv[2]; st[TI][4 * gq + 3] *= dv[3]; } \
              asm volatile("s_waitcnt lgkmcnt(0)" ::: "memory"); __builtin_amdgcn_sched_barrier(0); \
              st[TI] = MFMA32(PKV(a0, c0), vf[0], st[TI]); st[TI] = MFMA32(PKV(a1, c1), vf[1], st[TI]); st[TI] = MFMA32(PKV(a2, c2), vf[2], st[TI]); st[TI] = MFMA32(PKV(a3, c3), vf[3], st[TI]); } while (0)
          KE_TILE(0); KE_TILE(1); KE_TILE(2); KE_TILE(3);
#undef KE_TILE
#undef PKV
        }
        GLA_BAR();
    }
#undef GLOAD
}
}

template <int DIR> DI void gla_naive_unit(int b, int h, const bf16_t* gqkv, const _Float16* bc, bf16_t* oo, unsigned char* ldsg) {
    const int tid = threadIdx.x;
    float* qs = (float*)ldsg; float* ks = qs + 64 * 128; float* as = ks + 64 * 128;
    float s[128];
#pragma unroll
    for (int i = 0; i < 128; ++i) s[i] = 0.f;
    for (int ci = 0; ci < 64; ++ci) {
        const int chunk = DIR ? 63 - ci : ci; const long row0 = (long)b * SEQ + chunk * 64;
        __syncthreads();
        { const int t = tid >> 3, g = tid & 7; const long row = row0 + t;
          const bf16_t* qp = gqkv + row * 2048 + h * 128 + g * 16; const bf16_t* kp = qp + 512;
          const int tp = DIR ? t + 1 : t - 1; const bool hasp = DIR ? (t < 63) : (t > 0);
          const _Float16* bp = bc + row * 512 + h * 128 + g * 16; const _Float16* bpp = bc + (row0 + (hasp ? tp : t)) * 512 + h * 128 + g * 16;
          float qf[16], kf[16];
          unpack8(*(const u32x4*)qp, qf); unpack8(*(const u32x4*)(qp + 8), qf + 8); unpack8(*(const u32x4*)kp, kf); unpack8(*(const u32x4*)(kp + 8), kf + 8);
          const f16x8 b0 = *(const f16x8*)bp, b1 = *(const f16x8*)(bp + 8), c0 = *(const f16x8*)bpp, c1 = *(const f16x8*)(bpp + 8);
#pragma unroll
          for (int j = 0; j < 16; ++j) {
              const float bb = (float)(j < 8 ? b0[j & 7] : b1[j & 7]), cc = hasp ? (float)(j < 8 ? c0[j & 7] : c1[j & 7]) : 0.f;
              qs[t * 128 + g * 16 + j] = qf[j] * GLA_QSCALE; ks[t * 128 + g * 16 + j] = kf[j]; as[t * 128 + g * 16 + j] = exp2f(bb - cc);
          } }
        __syncthreads();
        if (tid < 256) {
            for (int tt = 0; tt < 64; ++tt) {
                const int t = DIR ? 63 - tt : tt; const long row = row0 + t;
                const float v = bf2f(gqkv[row * 2048 + 1024 + h * 256 + tid]);
                float o = 0.f;
                const f32x4* q4 = (const f32x4*)(qs + t * 128); const f32x4* k4 = (const f32x4*)(ks + t * 128); const f32x4* a4 = (const f32x4*)(as + t * 128);
#pragma unroll
                for (int d4 = 0; d4 < 32; ++d4) { const f32x4 q = q4[d4], k = k4[d4], a = a4[d4];
#pragma unroll
                    for (int e = 0; e < 4; ++e) {
                        if (DIR == 0) { s[4 * d4 + e] = fmaf(s[4 * d4 + e], a[e], k[e] * v); o = fmaf(q[e], s[4 * d4 + e], o); }
                        else { const float sd = s[4 * d4 + e] * a[e]; o = fmaf(q[e], sd, o); s[4 * d4 + e] = fmaf(k[e], v, sd); } }
                    if ((d4 & 3) == 3) asm volatile("" ::: "memory"); }
                oo[row * 1024 + h * 256 + tid] = (bf16_t)(cvt_pk_bf16(o, 0.f) & 0xffffu);
            }
        }
    }
    __syncthreads();
}

DI void tr_item(const float* W, int ldw, int col0, int K, bf16_t* WT, int drow0, const float* gs, LAS float* scr, int item, int nblk, int lane, int ldt = 0) {
    if (ldt == 0) ldt = K;
    const int kb = item / nblk, nb = item - kb * nblk, k0 = 64 * kb, n0 = 32 * nb;
#pragma unroll
    for (int i = 0; i < 32; ++i) { const int kk = 2 * i + (lane >> 5); float w = __builtin_nontemporal_load(W + (size_t)(k0 + kk) * ldw + col0 + n0 + (lane & 31)); if (gs) w *= gs[k0 + kk]; scr[kk * 33 + (lane & 31)] = w; }
    LDS_WAIT(); asm volatile("" ::: "memory");
    const int c = lane & 7;
#pragma unroll
    for (int j = 0; j < 4; ++j) { const int n = (lane >> 3) + 8 * j; const LAS float* s = scr + (8 * c) * 33 + n;
        u32x4 o; o.x = cvt_pk_bf16(s[0 * 33], s[1 * 33]); o.y = cvt_pk_bf16(s[2 * 33], s[3 * 33]); o.z = cvt_pk_bf16(s[4 * 33], s[5 * 33]); o.w = cvt_pk_bf16(s[6 * 33], s[7 * 33]);
        const int ng = drow0 + n0 + n;
        if (ldt > 0) *(u32x4*)(WT + (size_t)ng * ldt + k0 + 8 * c) = o;
        else *(u32x4*)(WT + (((size_t)(ng >> 8) * (size_t)(-ldt) + kb) * 256 + (ng & 255)) * 64 + 8 * c) = o; }
    LDS_WAIT(); asm volatile("" ::: "memory");
}
DI float logsigmoidf_(float x) { return fminf(x, 0.f) - log1pf(expf(-fabsf(x))); }

#define XB_TMO      128
#define XB_XCNT(j)  (256  + 64 * (j))
#define XB_XSUB(j)  (1280 + 64 * (j))
#define XB_XGEN(j)  (2304 + 64 * (j))
#define XB_TOP      3328
#define XB_TOPGEN   3392
#define XCD_BAR_WORDS 3456
#define XB_SPIN_CAP (1u << 18)

__device__ __forceinline__ unsigned xb_ld(unsigned* p)              { return __hip_atomic_load(p, __ATOMIC_RELAXED, __HIP_MEMORY_SCOPE_AGENT); }
__device__ __forceinline__ unsigned xb_add(unsigned* p, unsigned v) { return __hip_atomic_fetch_add(p, v, __ATOMIC_RELAXED, __HIP_MEMORY_SCOPE_AGENT); }
__device__ __forceinline__ unsigned xb_xcc_id() { return (unsigned)__builtin_amdgcn_s_getreg((3 << 11) | 20) & 0xFu; }
#define XB_SPIN(cond, bar) do { unsigned _sp = 0; while (cond) { __builtin_amdgcn_s_sleep(1); \
    if ((++_sp & 255u) == 0u) { if (xb_ld(&(bar)[XB_TMO])) break; if (_sp > XB_SPIN_CAP) { atomicAdd(&(bar)[XB_TMO], 1u); break; } } } } while (0)

struct XcdBarrier {
    unsigned* bar; unsigned x;
    volatile LAS unsigned* st;
};

__device__ __forceinline__ XcdBarrier xcd_barrier_post(unsigned* bar, volatile LAS unsigned* st) {
    XcdBarrier b; b.bar = bar; b.x = xb_xcc_id(); b.st = st;
    if (threadIdx.x == 0) (void)xb_add(&bar[XB_XCNT(b.x)], 1u);
    return b;
}
__device__ __forceinline__ void xcd_barrier_complete(unsigned* bar, unsigned x, unsigned& nloc, unsigned& nx) {
    const unsigned G = gridDim.x * gridDim.y * gridDim.z;
    unsigned sum, cnt, mine, sp = 0u;
    for (;;) {
        sum = 0u; cnt = 0u; mine = 0u;
#pragma unroll
        for (unsigned j = 0; j < 16; ++j) { const unsigned c = xb_ld(&bar[XB_XCNT(j)]); sum += c; cnt += (c > 0u) ? 1u : 0u; mine = (j == x) ? c : mine; }
        if (sum == G) break;
        __builtin_amdgcn_s_sleep(1);
        if ((++sp & 255u) == 0u) { if (xb_ld(&bar[XB_TMO])) break; if (sp > XB_SPIN_CAP) { atomicAdd(&bar[XB_TMO], 1u); break; } }
    }
    nloc = mine > 0u ? mine : 1u; nx = cnt > 0u ? cnt : 1u;
}

__device__ __forceinline__ void xcd_barrier(const XcdBarrier& b) {
    asm volatile("s_waitcnt vmcnt(0)" ::: "memory");
    __syncthreads();
    if (threadIdx.x == 0) {
        unsigned* bar = b.bar;
        __builtin_amdgcn_s_waitcnt(0);
        unsigned nloc = b.st[0], nx = b.st[1];
        if (nloc == 0u) { xcd_barrier_complete(bar, b.x, nloc, nx); b.st[0] = nloc; b.st[1] = nx; }
        const unsigned old = xb_add(&bar[XB_XSUB(b.x)], 1u);
        const unsigned gen = old / nloc;
        if (old + 1u == (gen + 1u) * nloc) {
            __builtin_amdgcn_fence(__ATOMIC_RELEASE, "agent");
            asm volatile("s_waitcnt vmcnt(0)" ::: "memory");
            const unsigned og = xb_add(&bar[XB_TOP], 1u);
            const unsigned tg = og / nx;
            if (og + 1u == (tg + 1u) * nx) xb_add(&bar[XB_TOPGEN], 1u);
            else XB_SPIN(xb_ld(&bar[XB_TOPGEN]) == tg, bar);
            __builtin_amdgcn_fence(__ATOMIC_ACQUIRE, "agent");
            xb_add(&bar[XB_XGEN(b.x)], 1u);
            asm volatile("s_waitcnt vmcnt(0)" ::: "memory");
        } else {
            XB_SPIN(xb_ld(&bar[XB_XGEN(b.x)]) == gen, bar);
            __builtin_amdgcn_fence(__ATOMIC_ACQUIRE, "agent");
            asm volatile("s_waitcnt vmcnt(0)" ::: "memory");
        }
    }
    __syncthreads();
}

constexpr int NPHASE = 10;
__global__ void __launch_bounds__(NTHR, 2) fwd_megakernel(Args a) {
    extern __shared__ __attribute__((aligned(16))) unsigned char lds[];
    cg::grid_group grid = cg::this_grid();
    LAS unsigned char* ldsl = (LAS unsigned char*)lds;
    const int tid = threadIdx.x, lane = tid & 63, wave = __builtin_amdgcn_readfirstlane(tid >> 6);
    const int G = gridDim.x, bid = blockIdx.x;
    const int gw = bid * NWAVES + wave, NGW = G * NWAVES; const long gt = (long)bid * NTHR + tid, NGT = (long)G * NTHR;
#define WSP(T_, off) ((T_*)(a.ws + (off)))
#define WinA WSP(bf16_t, WS_WINA)
#define WinB WSP(bf16_t, WS_WINB)
#define Wuq WSP(bf16_t, WS_WUQ)
#define Wukv WSP(bf16_t, WS_WUKV)
#define Wout WSP(bf16_t, WS_WOUT)
#define W1 WSP(bf16_t, WS_W1)
#define W2 WSP(bf16_t, WS_W2)
#define ropec WSP(float, WS_ROPEC)
#define ropes WSP(float, WS_ROPES)
#define ssq_q WSP(float, WS_SSQ)
#define ssq_kv (WSP(float, WS_SSQ) + T)
#define ssq_h (WSP(float, WS_SSQ) + 2 * T)
#define ssq_h2 (WSP(float, WS_SSQ) + 3 * T)
#define ctl WSP(int, WS_CTL)
#define XN WSP(bf16_t, WS_XN)
#define MERGED WSP(bf16_t, WS_MERGED)
#define GQKV WSP(bf16_t, WS_GQKV)
#define KB WSP(bf16_t, WS_K)
#define VB WSP(bf16_t, WS_V)
#define GATES WSP(bf16_t, WS_GATES)
#define UB WSP(bf16_t, WS_U)
#define QO WSP(bf16_t, WS_QO)
#define SMALL WSP(bf16_t, WS_SMALL)
#define OB WSP(bf16_t, WS_OB)
#define HB WSP(bf16_t, WS_HB)
#define BCF ((_Float16*)a.out)
#define BCB ((_Float16*)a.out + (size_t)T * 512)
#define OF ((bf16_t*)((unsigned char*)a.out + 64 * MiB))
    const int lo = a.ph_lo, hi_ = a.ph_hi;
    LAS int* misc = (LAS int*)(ldsl + LDS_MISC);
    if (tid == 0) { const int x = (int)(__builtin_amdgcn_s_getreg((3 << 11) | 20) & 0xFu); misc[0] = x; misc[1] = atomicAdd(ctl + 16 + x, 1); }
    if (tid == 0) { misc[8] = 0; misc[9] = 0; }
    __syncthreads();
    int cvirt = bid;
    const XcdBarrier xbar = xcd_barrier_post((unsigned*)(ctl + 1024), (volatile LAS unsigned*)(misc + 8));
#ifndef DBG_MASK
#define DBG_MASK 0x3ff
#endif
#define IN(k) (lo <= (k) && (k) < hi_ && ((DBG_MASK >> (k)) & 1))
#define SEAM(k) do { if (IN(k) && IN((k) + 1)) xcd_barrier(xbar); } while (0)

    if (IN(0)) {
        LAS float* scr = (LAS float*)(ldsl + wave * 16384);
        constexpr int J0 = 16 * 64, J1 = 16 * 22, J4 = 6 * 24, J5 = 4 * 48;
        constexpr int NITEMS = J0 + J1 + J4 + J5;
        for (int it = gw; it < NITEMS; it += NGW) {
            int r = it;
            if (r < J0) { tr_item(a.w_in, 5824, 0, 1024, WinA, 0, nullptr, scr, r, 64, lane); continue; } r -= J0;
            if (r < J1) { tr_item(a.w_in, 5824, 3072, 1024, WinA, 2048, nullptr, scr, r, 22, lane); continue; } r -= J1;
            if (r < J4) { tr_item(a.w_uq, 768, 0, 384, Wuq, 0, a.g_q, scr, r, 24, lane); continue; } r -= J4;
            tr_item(a.w_ukv, 1536, 0, 256, Wukv, 0, a.g_kv, scr, r, 48, lane);
        }
        for (long i = gt; i < 64 * 1024 / 8; i += NGT) *(u32x4*)(WinA + (size_t)2752 * 1024 + i * 8) = (u32x4){0u, 0u, 0u, 0u};
        for (int m0 = gw; m0 < T; m0 += 4 * NGW) {
            const f32x4* gr = (const f32x4*)a.g_mix + lane; f32x4 v[4][4];
#pragma unroll
            for (int k = 0; k < 4; ++k) { const int m = m0 + k * NGW; if (m < T) { const f32x4* xr = (const f32x4*)(a.x + (size_t)m * DM) + lane;
#pragma unroll
                for (int j = 0; j < 4; ++j) v[k][j] = __builtin_nontemporal_load(xr + 64 * j); } }
#pragma unroll
            for (int k = 0; k < 4; ++k) { const int m = m0 + k * NGW; if (m < T) { float s2 = 0.f;
#pragma unroll
                for (int j = 0; j < 4; ++j) s2 += (v[k][j].x * v[k][j].x + v[k][j].y * v[k][j].y) + (v[k][j].z * v[k][j].z + v[k][j].w * v[k][j].w);
                const float rstd = rsqrtf(wave_sum(s2) * (1.f / DM) + EPS);
                u32x2* o8 = (u32x2*)(XN + (size_t)m * DM) + lane;
#pragma unroll
                for (int j = 0; j < 4; ++j) { const f32x4 g = gr[64 * j]; const f32x4 w = v[k][j] * rstd * g; u32x2 p; p.x = cvt_pk_bf16(w.x, w.y); p.y = cvt_pk_bf16(w.z, w.w); o8[64 * j] = p; } } }
        }
        for (long i = gt; i < (long)T * 16; i += NGT) {
            const int t = (int)(i >> 4), k = (int)(i & 15);
            const float inv = exp2f(-(float)k * (13.287712379549449f / 16.0f)); const float ang = (float)a.pos[t] * inv;
            float sn, cs; sincosf(ang, &sn, &cs); ropec[i] = cs; ropes[i] = sn;
        }
        for (long i = gt; i < (long)T * 4; i += NGT) ssq_q[i] = 0.f;
    }
    SEAM(0);
    if (IN(0) && IN(1) && (G & 7) == 0) {
        bool ok = misc[0] < 8;
#pragma unroll
        for (int j = 0; j < 8; ++j) ok = ok && (__hip_atomic_load(ctl + 16 + j, __ATOMIC_RELAXED, __HIP_MEMORY_SCOPE_AGENT) == (G >> 3));
        if (ok) cvirt = misc[1] * 8 + misc[0];
    }
    if (IN(1)) {
        pg8::Gemm g{XN, WinA, T, NA, DM, DM, DM}; pg8::StaticOrder S; S.init(T, NA, G, cvirt);
        EpiP1a E{GQKV, SMALL, ssq_q, ssq_kv};
        pg8::gemm_phase<EpiP1a, pg8::StaticOrder, true, true>(ldsl, g, S, E);
    }
    SEAM(1);
    if (IN(2)) {
#ifndef DBG_P2
#define DBG_P2 15
#endif
        { pg8::Gemm g{SMALL + 32, Wuq, T, 768, 384, LDSM, 384}; pg8::StaticOrder S; S.init(T, 768, G, cvirt);
          EpiQ E{QO, ssq_q, ropec, ropes};
          pg8::gemm_phase<EpiQ, pg8::StaticOrder, true, true>(ldsl, g, S, E); }
        { pg8::Gemm g{SMALL + 416, Wukv, T, 1536, 256, LDSM, 256}; pg8::StaticOrder S; S.init(T, 1536, G, cvirt);
          EpiKV E{KB, VB, ssq_kv};
          pg8::gemm_phase<EpiKV, pg8::StaticOrder, true, true>(ldsl, g, S, E); }
        for (long i = gt; i < (long)T * 8; i += NGT) {
            const long t = i >> 3; const int h = (int)(i & 7);
            float x[32], c[16], sn[16];
            const bf16_t* kp = SMALL + t * LDSM + 672;
            unpack8(*(const u32x4*)kp, x); unpack8(*(const u32x4*)(kp + 8), x + 8); unpack8(*(const u32x4*)(kp + 16), x + 16); unpack8(*(const u32x4*)(kp + 24), x + 24);
#pragma unroll
            for (int q = 0; q < 4; ++q) { const f32x4 cv = *(const f32x4*)(ropec + t * 16 + 4 * q), sv = *(const f32x4*)(ropes + t * 16 + 4 * q);
                c[4 * q] = cv[0]; c[4 * q + 1] = cv[1]; c[4 * q + 2] = cv[2]; c[4 * q + 3] = cv[3]; sn[4 * q] = sv[0]; sn[4 * q + 1] = sv[1]; sn[4 * q + 2] = sv[2]; sn[4 * q + 3] = sv[3]; }
            float o[32];
#pragma unroll
            for (int k = 0; k < 16; ++k) { o[k] = x[k] * c[k] - x[16 + k] * sn[k]; o[16 + k] = x[k] * sn[k] + x[16 + k] * c[k]; }
            bf16_t* dst = KB + t * 768 + h * 96 + 64;
#pragma unroll
            for (int q = 0; q < 4; ++q) { u32x4 w; w.x = cvt_pk_bf16(o[8 * q], o[8 * q + 1]); w.y = cvt_pk_bf16(o[8 * q + 2], o[8 * q + 3]); w.z = cvt_pk_bf16(o[8 * q + 4], o[8 * q + 5]); w.w = cvt_pk_bf16(o[8 * q + 6], o[8 * q + 7]);
                *(u32x4*)(dst + 8 * q) = w; }
        }
        for (int unit = bid; unit < T / 64; unit += G) {
            float* zs = (float*)lds; const long row0 = (long)unit * 64;
            __syncthreads();
            { const int t = tid >> 3, c4 = (tid & 7) * 4; const u32x2 w = *(const u32x2*)(SMALL + (row0 + t) * LDSM + c4);
              zs[t * 32 + c4] = bflo(w.x); zs[t * 32 + c4 + 1] = bfhi(w.x); zs[t * 32 + c4 + 2] = bflo(w.y); zs[t * 32 + c4 + 3] = bfhi(w.y); }
            __syncthreads();
            float wf[16], wb[16];
#pragma unroll
            for (int r = 0; r < 16; ++r) { wf[r] = a.w_gate_f[r * 512 + tid]; wb[r] = a.w_gate_b[r * 512 + tid]; }
            const float bf_ = a.b_gate_f[tid], bb_ = a.b_gate_b[tid];
            float run = 0.f;
            for (int t = 0; t < 64; ++t) { float pre = bf_;
#pragma unroll
                for (int r = 0; r < 16; ++r) pre = fmaf(zs[t * 32 + r], wf[r], pre);
                run += logsig2_(pre) * (1.0f / 16.0f); __builtin_nontemporal_store((_Float16)run, BCF + (row0 + t) * 512 + tid); }
            run = 0.f;
            for (int t = 63; t >= 0; --t) { float pre = bb_;
#pragma unroll
                for (int r = 0; r < 16; ++r) pre = fmaf(zs[t * 32 + 16 + r], wb[r], pre);
                run += logsig2_(pre) * (1.0f / 16.0f); __builtin_nontemporal_store((_Float16)run, BCB + (row0 + t) * 512 + tid); }
        }
        __syncthreads();
    }
    SEAM(2);
    if (IN(3)) {
        LAS int* sidx = (LAS int*)(ldsl + LDS_MISC + 64);
#define FETCH(dst) do { __syncthreads(); if (tid == 0) *sidx = atomicAdd(ctl, 1); __syncthreads(); dst = *sidx; } while (0)
        int idx; FETCH(idx);
#ifndef DBG_NOGLA
        while (idx < 64) {
            const int b = idx >> 3, h = (idx >> 1) & 3;
#ifdef GLA_NAIVE
            if (idx & 1) gla_naive_unit<1>(b, h, GQKV, BCB, OB, lds); else gla_naive_unit<0>(b, h, GQKV, BCF, OF, lds);
#else
            if (idx & 1) gla::unit<1>(b, h, GQKV, BCB, OB, (char*)lds); else gla::unit<0>(b, h, GQKV, BCF, OF, (char*)lds);
#endif
            FETCH(idx);
        }
#endif
#ifndef DBG_NOATT
        while (idx < 64 + 1024) {
            const int u = idx - 64, bh = u >> 4, qb = u & 15, b = bh >> 3, h = bh & 7;
            const size_t rowq = (size_t)b * SEQ + qb * 256, rowk = (size_t)b * SEQ;
            att::attn_dense_body(QO + rowq * 1024 + h * 128, KB + rowk * 768 + h * 96, VB + rowk * 1024 + h * 128, QO + rowq * 1024 + h * 128, SEQ, (char*)lds);
            FETCH(idx);
        }
#endif
        {
            constexpr int J2 = 16 * 32, J3 = 16 * 64, J6 = 16 * 32, J7 = 16 * 128, J8 = 64 * 32, NLATE = J2 + J3 + J6 + J7 + J8, NFILL = NLATE / 16;
            static_assert(NLATE % 16 == 0, "filler units are 16 items each");
            LAS float* scr = (LAS float*)(ldsl + wave * 16384);
            while (idx < 64 + 1024 + NFILL) {
                const int base = (idx - (64 + 1024)) * 16 + wave * 2;
                for (int q = 0; q < 2; ++q) {
                    int r = base + q;
                    if (r < J2) { tr_item(a.w_in, 5824, 2048, 1024, WinB, 0, nullptr, scr, r, 32, lane); continue; } r -= J2;
                    if (r < J3) { tr_item(a.w_in, 5824, 3776, 1024, WinB, 1024, nullptr, scr, r, 64, lane); continue; } r -= J3;
                    if (r < J6) { tr_item(a.w_out, 1024, 0, 1024, Wout, 0, nullptr, scr, r, 32, lane); continue; } r -= J6;
                    if (r < J7) { tr_item(a.w_ff1, 4096, 0, 1024, W1, 0, a.g_mlp, scr, r, 128, lane); continue; } r -= J7;
                    tr_item(a.w_ff2, 1024, 0, 4096, W2, 0, nullptr, scr, r, 32, lane, -(DFF / 64));
                }
                FETCH(idx);
            }
        }
#undef FETCH
    }
    SEAM(3);
    if (IN(4)) {
        pg8::Gemm g{XN, WinB, T, NG, DM, DM, DM}; pg8::StaticOrder S; S.init(T, NG, G, cvirt);
        EpiGates E{GATES};
        pg8::gemm_phase<EpiGates, pg8::StaticOrder, true, true>(ldsl, g, S, E);
    }
    SEAM(4);
    if (IN(5)) {
        for (int m0 = gw; m0 < T; m0 += 2 * NGW) {
            u32x4 ld[2][12];
#pragma unroll
            for (int k = 0; k < 2; ++k) { const int m = m0 + k * NGW; if (m < T) { const size_t r1 = (size_t)m * 1024 + lane * 8; const bf16_t* gp = GATES + (size_t)m * NG + lane * 8;
#pragma unroll
                for (int j = 0; j < 2; ++j) { ld[k][6 * j + 0] = __builtin_nontemporal_load((const u32x4*)(OF + r1 + 512 * j)); ld[k][6 * j + 1] = __builtin_nontemporal_load((const u32x4*)(OB + r1 + 512 * j)); ld[k][6 * j + 2] = __builtin_nontemporal_load((const u32x4*)(QO + r1 + 512 * j));
                    ld[k][6 * j + 3] = __builtin_nontemporal_load((const u32x4*)(gp + 512 * j)); ld[k][6 * j + 4] = __builtin_nontemporal_load((const u32x4*)(gp + 1024 + 512 * j)); ld[k][6 * j + 5] = __builtin_nontemporal_load((const u32x4*)(gp + 2048 + 512 * j)); } } }
            f32x4 gg[2][2];
#pragma unroll
            for (int j = 0; j < 2; ++j) { gg[j][0] = *(const f32x4*)(a.g_gla + lane * 8 + 512 * j); gg[j][1] = *(const f32x4*)(a.g_gla + lane * 8 + 512 * j + 4); }
#pragma unroll
            for (int k = 0; k < 2; ++k) { const int m = m0 + k * NGW; if (m < T) { const size_t r1 = (size_t)m * 1024 + lane * 8;
#pragma unroll
                for (int j = 0; j < 2; ++j) {
                    float of[8], ob[8], ym[8], gr[8], za[8], zb[8];
                    unpack8(ld[k][6 * j + 0], of); unpack8(ld[k][6 * j + 1], ob); unpack8(ld[k][6 * j + 2], ym); unpack8(ld[k][6 * j + 3], gr); unpack8(ld[k][6 * j + 4], za); unpack8(ld[k][6 * j + 5], zb);
                    float s2 = 0.f;
#pragma unroll
                    for (int e = 0; e < 8; ++e) { of[e] += ob[e]; s2 += of[e] * of[e]; }
                    s2 += __shfl_xor(s2, 1); s2 += __shfl_xor(s2, 2); s2 += __shfl_xor(s2, 4); s2 += __shfl_xor(s2, 8); s2 += __shfl_xor(s2, 16);
                    const float rstd = rsqrtf(s2 * (1.f / 256.f) + EPS);
                    float res[8];
#pragma unroll
                    for (int e = 0; e < 8; ++e) { const float y = of[e] * rstd * gg[j][e >> 2][e & 3] * gr[e]; res[e] = za[e] * y + zb[e] * ym[e]; }
                    u32x4 w; w.x = cvt_pk_bf16(res[0], res[1]); w.y = cvt_pk_bf16(res[2], res[3]); w.z = cvt_pk_bf16(res[4], res[5]); w.w = cvt_pk_bf16(res[6], res[7]);
                    *(u32x4*)(MERGED + r1 + 512 * j) = w; } } }
        }
    }
    SEAM(5);
    if (IN(6)) {
        pg8::Gemm g{MERGED, Wout, T, DM, DM, DM, DM}; pg8::StaticOrder S; S.init(T, DM, G, cvirt);
        EpiResB<false> E{a.x, HB, ssq_h};
        pg8::gemm_phase<EpiResB<false>, pg8::StaticOrder, true, true>(ldsl, g, S, E);
    }
    SEAM(6);
    if (IN(7)) {
        pg8::Gemm g{HB, W1, T, DFF, DM, DM, DM}; pg8::StaticOrder S; S.init(T, DFF, G, cvirt);
        EpiFF1 E{UB, ssq_h};
        pg8::gemm_phase<EpiFF1, pg8::StaticOrder, true, true>(ldsl, g, S, E);
    }
    SEAM(7);
    if (IN(8)) {
        pg8::Gemm g{UB, W2, T, DM, DFF, 64, 64, 256u * 64u * 2u, (unsigned)(DFF / 64) * 256u * 64u * 2u, 256u * 64u * 2u, (unsigned)(DFF / 64) * 256u * 64u * 2u}; pg8::ReverseOrder S; S.init(T, DM, G, cvirt);
        EpiResB<true> E{HB, MERGED, nullptr};
        pg8::gemm_phase<EpiResB<true>, pg8::ReverseOrder, true, true>(ldsl, g, S, E);
    }
    SEAM(8);
    if (IN(9)) {
        for (int m0 = gw; m0 < T; m0 += 8 * NGW) {
            u32x2 v[8][4];
#pragma unroll
            for (int k = 0; k < 8; ++k) { const int m = m0 + k * NGW; if (m < T) { const u32x2* hp = (const u32x2*)(MERGED + (size_t)m * DM) + lane;
#pragma unroll
                for (int j = 0; j < 4; ++j) v[k][j] = __builtin_nontemporal_load(hp + 64 * j); } }
            f32x4 g4[4];
#pragma unroll
            for (int j = 0; j < 4; ++j) g4[j] = ((const f32x4*)a.g_final)[lane + 64 * j];
#pragma unroll
            for (int k = 0; k < 8; ++k) { const int m = m0 + k * NGW; if (m < T) {
                float s2 = 0.f;
#pragma unroll
                for (int j = 0; j < 4; ++j) { const float f0 = bflo(v[k][j].x), f1 = bfhi(v[k][j].x), f2 = bflo(v[k][j].y), f3 = bfhi(v[k][j].y); s2 += (f0 * f0 + f1 * f1) + (f2 * f2 + f3 * f3); }
                const float rstd = rsqrtf(wave_sum(s2) * (1.f / DM) + EPS); f32x4* op = (f32x4*)(a.out + (size_t)m * DM) + lane;
#pragma unroll
                for (int j = 0; j < 4; ++j) __builtin_nontemporal_store((f32x4){bflo(v[k][j].x), bfhi(v[k][j].x), bflo(v[k][j].y), bfhi(v[k][j].y)} * rstd * g4[j], op + 64 * j); } }
        }
    }
    if (a.ph_hi > NPHASE) grid.sync();
#undef IN
#undef SEAM
}

#ifndef MK_PER_PHASE
#define MK_PER_PHASE 0
#endif
extern "C" void kernel_launch(void* const* d_in, const int* in_sizes, int n_in, void* d_out, int out_size, void* d_ws, size_t ws_size, hipStream_t stream) {
    static int grid = 0;
    if (grid == 0) {
        if (n_in != 18 || in_sizes[0] != T * DM || out_size != T * DM || ws_size < WS_END) { fprintf(stderr, "kernel_launch: unexpected shapes (n_in %d in0 %d out %d ws %zu)\n", n_in, n_in > 0 ? in_sizes[0] : -1, out_size, ws_size); grid = -1; return; }
        int dev = 0, cus = 0, per_cu = 0;
        hipGetDevice(&dev); hipDeviceGetAttribute(&cus, hipDeviceAttributeMultiprocessorCount, dev);
        if (hipFuncSetAttribute((const void*)fwd_megakernel, hipFuncAttributeMaxDynamicSharedMemorySize, LDS_BYTES) != hipSuccess) { fprintf(stderr, "kernel_launch: hipFuncSetAttribute failed\n"); grid = -1; return; }
        if (hipOccupancyMaxActiveBlocksPerMultiprocessor(&per_cu, (const void*)fwd_megakernel, NTHR, LDS_BYTES) != hipSuccess || per_cu < 1) { fprintf(stderr, "kernel_launch: occupancy query says %d\n", per_cu); per_cu = 1; }
        (void)hipGetLastError();
        grid = cus * 1;
    }
    if (grid < 0) return;
    if (hipMemsetAsync((char*)d_ws + WS_CTL, 0, 32768, stream) != hipSuccess) { fprintf(stderr, "kernel_launch: memset failed\n"); return; }
    Args a{};
    a.x = (const float*)d_in[0]; a.pos = (const int*)d_in[1]; a.g_mix = (const float*)d_in[2]; a.w_in = (const float*)d_in[3]; a.w_gate_f = (const float*)d_in[4]; a.b_gate_f = (const float*)d_in[5];
    a.w_gate_b = (const float*)d_in[6]; a.b_gate_b = (const float*)d_in[7]; a.g_gla = (const float*)d_in[8]; a.g_q = (const float*)d_in[9]; a.w_uq = (const float*)d_in[10]; a.g_kv = (const float*)d_in[11];
    a.w_ukv = (const float*)d_in[12]; a.w_out = (const float*)d_in[13]; a.g_mlp = (const float*)d_in[14]; a.w_ff1 = (const float*)d_in[15]; a.w_ff2 = (const float*)d_in[16]; a.g_final = (const float*)d_in[17];
    a.out = (float*)d_out; a.ws = (unsigned char*)d_ws;
#if MK_PER_PHASE
    for (int p = 0; p < NPHASE; ++p) { a.ph_lo = p; a.ph_hi = p + 1; hipLaunchKernelGGL(fwd_megakernel, dim3(grid), dim3(NTHR), LDS_BYTES, stream, a); }
#else
    a.ph_lo = 0; a.ph_hi = NPHASE;
    void* args[] = {&a};
    hipError_t e = hipLaunchCooperativeKernel((const void*)fwd_megakernel, dim3(grid), dim3(NTHR), args, LDS_BYTES, stream);
    if (e != hipSuccess) fprintf(stderr, "kernel_launch: cooperative launch failed: %s (grid %d)\n", hipGetErrorString(e), grid);
#endif
}
```
